# Optimizing an MI355X kernel written in HIP

```python
import math
import jax, jax.numpy as jnp
from jax import lax
import numpy as np

D_MODEL = 1024
BATCH = 4
SEQ = 8192
DEPTH = 2
DEC_BATCH = 128
DEC_SEQ = 8
PAST_LEN = 16384
PAGE_SIZE = 128

N_META = 16
EPS = 1e-6
POOL_GROUPS = 4
POOL_GROUP_DIM = D_MODEL // 8
POOL_WIDTH = POOL_GROUPS * POOL_GROUP_DIM
POOL_WINDOWS = (2, 4, 8, 16)
POOL_BUF = max(POOL_WINDOWS) - 1
DN_HEADS = 4
DN_DK = 128
DN_DV = 128
DN_QK = DN_HEADS * DN_DK
DN_VW = DN_HEADS * DN_DV
CONV_W = 4
CONV_CH = 2 * DN_QK + DN_VW
DN_CHUNK = 64
SWA_HEADS = 8
SWA_KV_HEADS = 2
SWA_GROUP = SWA_HEADS // SWA_KV_HEADS
SWA_HD = 64
SWA_WIDTH = SWA_HEADS * SWA_HD
SWA_KV_WIDTH = SWA_KV_HEADS * SWA_HD
SWA_WINDOW = 128
SWA_BLOCK = 128
ROPE_THETA = 10000.0
D_FF = 4 * D_MODEL
IN_SPLITS = (POOL_WIDTH, DN_QK, DN_QK, DN_VW, DN_VW, DN_HEADS, DN_HEADS,
             SWA_WIDTH, SWA_KV_WIDTH, SWA_KV_WIDTH, D_MODEL, D_MODEL, D_MODEL)
D_IN = sum(IN_SPLITS)

kernel_name = 'hybrid_pool_delta_swa_decode_step'


def rmsnorm(x, w):
    xf = x.astype(jnp.float32)
    y = xf * lax.rsqrt(jnp.mean(xf * xf, axis=-1, keepdims=True) + EPS)
    return (y * w.astype(jnp.float32)).astype(x.dtype)


def l2norm(x):
    xf = x.astype(jnp.float32)
    return (xf * lax.rsqrt(jnp.sum(xf * xf, axis=-1, keepdims=True) + EPS)).astype(x.dtype)


def rope(x, pos):
    half = x.shape[-1] // 2
    inv = ROPE_THETA ** (-jnp.arange(half, dtype=jnp.float32) / half)
    ang = pos.astype(jnp.float32)[:, None] * inv[None, :]
    cos = jnp.cos(ang)[None, :, None, :]
    sin = jnp.sin(ang)[None, :, None, :]
    xf = x.astype(jnp.float32)
    x1, x2 = xf[..., :half], xf[..., half:]
    return jnp.concatenate([x1 * cos - x2 * sin, x2 * cos + x1 * sin], axis=-1).astype(x.dtype)


def pool_mix(u, buf, pos0, w_pool, s_pool):
    B, T, _ = u.shape
    ext = jnp.concatenate([buf.astype(u.dtype), u], axis=1).astype(jnp.float32)
    c = jnp.cumsum(jnp.pad(ext, ((0, 0), (1, 0), (0, 0))), axis=1)
    end = c[:, POOL_BUF + 1:]
    pos = pos0 + jnp.arange(T)
    means = []
    for g, w in enumerate(POOL_WINDOWS):
        sl = slice(g * POOL_GROUP_DIM, (g + 1) * POOL_GROUP_DIM)
        start = c[:, POOL_BUF + 1 - w:POOL_BUF + 1 - w + T, sl]
        cnt = jnp.minimum(w, pos + 1).astype(jnp.float32)[None, :, None]
        means.append((end[..., sl] - start) / cnt)
    d = (jnp.concatenate(means, axis=-1) - ext[:, POOL_BUF:]).astype(u.dtype)
    d = d.reshape(B, T, POOL_GROUPS, POOL_GROUP_DIM)
    y = jnp.einsum('btgc,gcd->btgd', d, w_pool).reshape(B, T, POOL_WIDTH)
    return y * s_pool, ext[:, -POOL_BUF:].astype(u.dtype)


def short_conv(u, buf, w_conv):
    T = u.shape[1]
    ext = jnp.concatenate([buf.astype(u.dtype), u], axis=1)
    y = ext[:, 0:T] * w_conv[0]
    for j in range(1, CONV_W):
        y = y + ext[:, j:j + T] * w_conv[j]
    return jax.nn.silu(y), ext[:, T:]


def gated_delta(q, k, v, g, beta, S0, chunk):
    B, T, H, _ = q.shape
    DV = v.shape[-1]
    N = T // chunk
    f32 = jnp.float32

    def blk(x):
        return x.astype(f32).reshape(B, N, chunk, H, -1).transpose(1, 0, 3, 2, 4)

    qc, kc, vc = blk(q), blk(k), blk(v)
    gc = g.astype(f32).reshape(B, N, chunk, H).transpose(1, 0, 3, 2)
    bc = beta.astype(f32).reshape(B, N, chunk, H).transpose(1, 0, 3, 2)
    G = jnp.cumsum(gc, axis=-1)
    tri = jnp.tril(jnp.ones((chunk, chunk), bool))
    strict = jnp.tril(jnp.ones((chunk, chunk), bool), -1)
    decay = jnp.exp(jnp.where(tri, G[..., :, None] - G[..., None, :], -jnp.inf))
    kk = jnp.einsum('nbhid,nbhjd->nbhij', kc, kc)
    M = jnp.where(strict, kk * decay * bc[..., :, None], 0.0)
    eye = jnp.eye(chunk, dtype=f32)
    Tinv = lax.linalg.triangular_solve(eye + M, jnp.broadcast_to(eye, M.shape),
                                       left_side=True, lower=True, unit_diagonal=True)
    u = Tinv @ (vc * bc[..., None])
    w = Tinv @ (kc * (bc * jnp.exp(G))[..., None])
    qk = jnp.einsum('nbhid,nbhjd->nbhij', qc, kc) * decay
    qg = qc * jnp.exp(G)[..., None]
    kg = kc * jnp.exp(G[..., -1:] - G)[..., None]
    gl = jnp.exp(G[..., -1])

    def step(S, xs):
        qk_i, qg_i, kg_i, u_i, w_i, gl_i = xs
        dlt = u_i - w_i @ S
        o = qg_i @ S + qk_i @ dlt
        S = S * gl_i[..., None, None] + jnp.swapaxes(kg_i, -1, -2) @ dlt
        return S, o

    S, o = lax.scan(step, S0.astype(f32), (qk, qg, kg, u, w, gl))
    o = o.transpose(1, 0, 3, 2, 4).reshape(B, T, H, DV)
    return o.astype(v.dtype), S


def deltanet(q, k, v, z, b, a, conv_buf, S0, conv_w, a_log, dt_bias, onorm_w, segments):
    B, T, _ = q.shape
    qkv, conv_new = short_conv(jnp.concatenate([q, k, v], axis=-1), conv_buf, conv_w)
    q, k, v = jnp.split(qkv, [DN_QK, 2 * DN_QK], axis=-1)
    q = l2norm(q.reshape(B, T, DN_HEADS, DN_DK)) * (DN_DK ** -0.5)
    k = l2norm(k.reshape(B, T, DN_HEADS, DN_DK))
    v = v.reshape(B, T, DN_HEADS, DN_DV)
    beta = jax.nn.sigmoid(b.astype(jnp.float32))
    g = -jnp.exp(a_log.astype(jnp.float32)) * jax.nn.softplus(a.astype(jnp.float32) + dt_bias.astype(jnp.float32))
    S = S0
    outs = []
    start = 0
    for length, chunk in segments:
        sl = slice(start, start + length)
        o, S = gated_delta(q[:, sl], k[:, sl], v[:, sl], g[:, sl], beta[:, sl], S, chunk)
        outs.append(o)
        start += length
    o = jnp.concatenate(outs, axis=1)
    o = rmsnorm(o, onorm_w) * jax.nn.silu(z.reshape(B, T, DN_HEADS, DN_DV))
    return o.reshape(B, T, DN_VW), conv_new, S.astype(S0.dtype)


def sink_probs(s, mask, sink):
    s = jnp.where(mask, s, -jnp.inf)
    m = jnp.maximum(jnp.max(s, axis=-1, keepdims=True), sink)
    e = jnp.exp(s - m)
    return e / (jnp.sum(e, axis=-1, keepdims=True) + jnp.exp(sink - m))


def swa_prompt(q, k, v, sinks):
    B, L = q.shape[:2]
    P = (-L) % SWA_BLOCK
    nb = (L + P) // SWA_BLOCK
    f32 = jnp.float32
    qb = jnp.pad(q, ((0, 0), (P, 0), (0, 0), (0, 0))).reshape(B, nb, SWA_BLOCK, SWA_KV_HEADS, SWA_GROUP, SWA_HD)
    kp = jnp.pad(k, ((0, 0), (P + SWA_BLOCK, 0), (0, 0), (0, 0))).reshape(B, nb + 1, SWA_BLOCK, SWA_KV_HEADS, SWA_HD)
    vp = jnp.pad(v, ((0, 0), (P + SWA_BLOCK, 0), (0, 0), (0, 0))).reshape(B, nb + 1, SWA_BLOCK, SWA_KV_HEADS, SWA_HD)
    kw = jnp.concatenate([kp[:, :-1], kp[:, 1:]], axis=2)
    vw = jnp.concatenate([vp[:, :-1], vp[:, 1:]], axis=2)
    s = jnp.einsum('bnqkgd,bnjkd->bnkgqj', qb.astype(f32), kw.astype(f32)) * (SWA_HD ** -0.5)
    r = jnp.arange(SWA_BLOCK)[:, None]
    j = jnp.arange(2 * SWA_BLOCK)[None, :]
    diff = r - j + SWA_BLOCK
    kpos = jnp.arange(nb)[:, None, None] * SWA_BLOCK + j[None] - SWA_BLOCK - P
    mask = (diff >= 0) & (diff < SWA_WINDOW) & (kpos >= 0)
    sink = sinks.astype(f32).reshape(SWA_KV_HEADS, SWA_GROUP)[None, None, :, :, None, None]
    prob = sink_probs(s, mask[None, :, None, None], sink)
    o = jnp.einsum('bnkgqj,bnjkd->bnqkgd', prob, vw.astype(f32)).reshape(B, nb * SWA_BLOCK, SWA_WIDTH)
    return o[:, P:].astype(q.dtype)


def swa_sample(q, k, v, k_buf, v_buf, sinks):
    B, T = q.shape[:2]
    W = k_buf.shape[1]
    f32 = jnp.float32
    ke = jnp.concatenate([k_buf.astype(k.dtype), k], axis=1)
    ve = jnp.concatenate([v_buf.astype(v.dtype), v], axis=1)
    qg = q.reshape(B, T, SWA_KV_HEADS, SWA_GROUP, SWA_HD)
    s = jnp.einsum('btkgd,bjkd->bkgtj', qg.astype(f32), ke.astype(f32)) * (SWA_HD ** -0.5)
    diff = (jnp.arange(T)[:, None] + W) - jnp.arange(W + T)[None, :]
    mask = (diff >= 0) & (diff < SWA_WINDOW)
    sink = sinks.astype(f32).reshape(SWA_KV_HEADS, SWA_GROUP)[None, :, :, None, None]
    prob = sink_probs(s, mask, sink)
    o = jnp.einsum('bkgtj,bjkd->btkgd', prob, ve.astype(f32)).reshape(B, T, SWA_WIDTH)
    return o.astype(q.dtype), ke[:, -W:], ve[:, -W:]


def mixer(xn, p, pos0, pool_buf, conv_buf, S0, k_buf, v_buf, is_prompt):
    B, T, _ = xn.shape
    h = xn @ p['w_in']
    (u_a, q_b, k_b, v_b, z_b, b_b, a_b, q_c, k_c, v_c, g_a, g_b, g_c) = jnp.split(
        h, np.cumsum(IN_SPLITS)[:-1].tolist(), axis=-1)
    o_a, pool_new = pool_mix(u_a, pool_buf, pos0, p['pool_w'], p['pool_scale'])
    segments = ((N_META, N_META), (T - N_META, DN_CHUNK)) if is_prompt else ((T, T),)
    o_b, conv_new, S_new = deltanet(q_b, k_b, v_b, z_b, b_b, a_b, conv_buf, S0, p['dn_conv_w'],
                                    p['dn_a_log'], p['dn_dt_bias'], p['dn_onorm_w'], segments)
    pos = pos0 + jnp.arange(T)
    qh = rope(q_c.reshape(B, T, SWA_HEADS, SWA_HD), pos)
    kh = rope(k_c.reshape(B, T, SWA_KV_HEADS, SWA_HD), pos)
    vh = v_c.reshape(B, T, SWA_KV_HEADS, SWA_HD)
    if is_prompt:
        o_c = swa_prompt(qh, kh, vh, p['swa_sinks'])
        k_new, v_new = kh[:, -SWA_WINDOW:], vh[:, -SWA_WINDOW:]
    else:
        o_c, k_new, v_new = swa_sample(qh, kh, vh, k_buf, v_buf, p['swa_sinks'])
    m = (jax.nn.sigmoid(g_a) * (o_a @ p['proj_a'])
         + jax.nn.sigmoid(g_b) * (o_b @ p['proj_b'])
         + jax.nn.sigmoid(g_c) * (o_c @ p['proj_c']))
    return m @ p['w_out'], (pool_new, conv_new, S_new, k_new, v_new)


def block(x, p, pos0, pool_buf, conv_buf, S0, k_buf, v_buf, is_prompt):
    mix, new = mixer(rmsnorm(x, p['norm1_w']), p, pos0, pool_buf, conv_buf, S0, k_buf, v_buf, is_prompt)
    h = x + mix
    f = jnp.square(jax.nn.relu(rmsnorm(h, p['norm2_w']) @ p['w_up'])) @ p['w_down']
    return h + f, new


def setup_inputs(seed: int = 0) -> dict:
    key = jax.random.key(seed)
    ks = list(jax.random.split(key, 32))

    def nrm(i, shape, scale):
        return jax.random.normal(ks[i], shape, jnp.float32) * scale

    swa_buf = min(SWA_WINDOW, PAST_LEN)
    dt = jnp.exp(jax.random.uniform(ks[10], (DEPTH, DN_HEADS), jnp.float32, math.log(1e-3), math.log(1e-1)))
    return {
        'x_prompt': nrm(0, (BATCH, SEQ, D_MODEL), 1.0),
        'x_sample': nrm(1, (DEC_BATCH, DEC_SEQ, D_MODEL), 1.0),
        'state_pool': nrm(2, (DEPTH, DEC_BATCH, POOL_BUF, POOL_WIDTH), 1.0),
        'state_conv': nrm(3, (DEPTH, DEC_BATCH, CONV_W - 1, CONV_CH), 1.0),
        'state_delta': nrm(4, (DEPTH, DEC_BATCH, DN_HEADS, DN_DK, DN_DV), DN_DK ** -0.5),
        'cache_swa_k': nrm(5, (DEPTH, DEC_BATCH, swa_buf, SWA_KV_HEADS, SWA_HD), 1.0),
        'cache_swa_v': nrm(6, (DEPTH, DEC_BATCH, swa_buf, SWA_KV_HEADS, SWA_HD), 1.0),
        'meta_tokens': nrm(7, (N_META, D_MODEL), 1.0),
        'norm1_w': 1.0 + nrm(8, (DEPTH, D_MODEL), 0.05),
        'w_in': nrm(9, (DEPTH, D_MODEL, D_IN), D_MODEL ** -0.5),
        'pool_w': nrm(11, (DEPTH, POOL_GROUPS, POOL_GROUP_DIM, POOL_GROUP_DIM), POOL_GROUP_DIM ** -0.5),
        'pool_scale': 1.0 + nrm(12, (DEPTH, POOL_WIDTH), 0.1),
        'dn_conv_w': nrm(13, (DEPTH, CONV_W, CONV_CH), CONV_W ** -0.5),
        'dn_a_log': jnp.log(jax.random.uniform(ks[14], (DEPTH, DN_HEADS), jnp.float32, 1.0, 16.0)),
        'dn_dt_bias': dt + jnp.log(-jnp.expm1(-dt)),
        'dn_onorm_w': 1.0 + nrm(15, (DEPTH, DN_DV), 0.05),
        'swa_sinks': nrm(16, (DEPTH, SWA_HEADS), 0.5),
        'proj_a': nrm(17, (DEPTH, POOL_WIDTH, D_MODEL), POOL_WIDTH ** -0.5),
        'proj_b': nrm(18, (DEPTH, DN_VW, D_MODEL), DN_VW ** -0.5),
        'proj_c': nrm(19, (DEPTH, SWA_WIDTH, D_MODEL), SWA_WIDTH ** -0.5),
        'w_out': nrm(20, (DEPTH, D_MODEL, D_MODEL), D_MODEL ** -0.5),
        'norm2_w': 1.0 + nrm(21, (DEPTH, D_MODEL), 0.05),
        'w_up': nrm(22, (DEPTH, D_MODEL, D_FF), D_MODEL ** -0.5),
        'w_down': nrm(23, (DEPTH, D_FF, D_MODEL), D_FF ** -0.5),
        'final_norm_w': 1.0 + nrm(24, (D_MODEL,), 0.05),
    }


def reference(x_prompt, x_sample, state_pool, state_conv, state_delta, cache_swa_k, cache_swa_v,
              meta_tokens, norm1_w, w_in, pool_w, pool_scale, dn_conv_w, dn_a_log, dn_dt_bias,
              dn_onorm_w, swa_sinks, proj_a, proj_b, proj_c, w_out, norm2_w, w_up, w_down, final_norm_w):
    Bp = x_prompt.shape[0]
    xp = jnp.concatenate([jnp.broadcast_to(meta_tokens[None].astype(x_prompt.dtype), (Bp, N_META, D_MODEL)),
                          x_prompt], axis=1)
    xs = x_sample
    new_p = []
    new_s = []
    for l in range(DEPTH):
        p = dict(norm1_w=norm1_w[l], w_in=w_in[l], pool_w=pool_w[l], pool_scale=pool_scale[l],
                 dn_conv_w=dn_conv_w[l], dn_a_log=dn_a_log[l], dn_dt_bias=dn_dt_bias[l],
                 dn_onorm_w=dn_onorm_w[l], swa_sinks=swa_sinks[l], proj_a=proj_a[l], proj_b=proj_b[l],
                 proj_c=proj_c[l], w_out=w_out[l], norm2_w=norm2_w[l], w_up=w_up[l], w_down=w_down[l])
        xp, st_p = block(xp, p, 0,
                         jnp.zeros((Bp, POOL_BUF, POOL_WIDTH), xp.dtype),
                         jnp.zeros((Bp, CONV_W - 1, CONV_CH), xp.dtype),
                         jnp.zeros((Bp, DN_HEADS, DN_DK, DN_DV), xp.dtype),
                         None, None, True)
        xs, st_s = block(xs, p, PAST_LEN, state_pool[l], state_conv[l], state_delta[l],
                         cache_swa_k[l], cache_swa_v[l], False)
        new_p.append(st_p)
        new_s.append(st_s)
    y_prompt = rmsnorm(xp, final_norm_w)[:, N_META:]
    y_sample = rmsnorm(xs, final_norm_w)
    pool_p = jnp.stack([st[0] for st in new_p])
    conv_p = jnp.stack([st[1] for st in new_p])
    delta_p = jnp.stack([st[2] for st in new_p])
    k_p = jnp.stack([st[3] for st in new_p])
    v_p = jnp.stack([st[4] for st in new_p])
    pool_s = jnp.stack([st[0] for st in new_s])
    conv_s = jnp.stack([st[1] for st in new_s])
    delta_s = jnp.stack([st[2] for st in new_s])
    k_s = jnp.stack([st[3] for st in new_s])
    v_s = jnp.stack([st[4] for st in new_s])
    return (y_prompt, y_sample, pool_p, conv_p, delta_p, k_p, v_p, pool_s, conv_s, delta_s, k_s, v_s)
```

```cpp
#include <hip/hip_runtime.h>
#include <hip/hip_cooperative_groups.h>
#include <cstdio>
#include <cstring>
namespace cg = cooperative_groups;

typedef unsigned short bfraw;
typedef __attribute__((ext_vector_type(8))) short bf16x8;
typedef __attribute__((ext_vector_type(4))) float f32x4;

#define NTHR 512
#ifndef ONE_LAUNCH
#define ONE_LAUNCH 1
#endif

constexpr int DM = 1024, TP = 8208, SEQ = 8192, NBP = 4, NBS = 128, TS = 8;
constexpr int ROWS_P = NBP * TP;
constexpr int ROWS = ROWS_P + NBS * TS;
constexpr int MP = 34048;
constexpr int D_IN = 6408, DFF = 4096;
constexpr int NCH = 129;
constexpr int NUNIT_P = NBP * NCH * 4;
constexpr int LD1 = 2048, LD2 = 1280;
constexpr float EPS = 1e-6f;

constexpr size_t O_YP = 0;
constexpr size_t O_YS = O_YP + (size_t)NBP * SEQ * DM;
constexpr size_t O_POOLP = O_YS + (size_t)NBS * TS * DM;
constexpr size_t O_CONVP = O_POOLP + 2 * 4 * 15 * 512;
constexpr size_t O_DELTAP = O_CONVP + 2 * 4 * 3 * 1536;
constexpr size_t O_KP = O_DELTAP + 2 * 4 * 4 * 128 * 128;
constexpr size_t O_VP = O_KP + 2 * 4 * 128 * 128;
constexpr size_t O_POOLS = O_VP + 2 * 4 * 128 * 128;
constexpr size_t O_CONVS = O_POOLS + (size_t)2 * 128 * 15 * 512;
constexpr size_t O_DELTAS = O_CONVS + (size_t)2 * 128 * 3 * 1536;
constexpr size_t O_KS = O_DELTAS + (size_t)2 * 128 * 4 * 128 * 128;
constexpr size_t O_VS = O_KS + (size_t)2 * 128 * 128 * 128;

constexpr size_t WS_W = 0;
constexpr int NIN = 3328;
constexpr size_t WE_IN = 0;
constexpr size_t WE_POOL = WE_IN + (size_t)(NIN + 3072) * 1024;
constexpr size_t WE_PA = WE_POOL + 4 * 128 * 128;
constexpr size_t WE_PB = WE_PA + 1024 * 512;
constexpr size_t WE_PC = WE_PB + 1024 * 512;
constexpr size_t WE_OUT = WE_PC + 1024 * 512;
constexpr size_t WE_UP = WE_OUT + 1024 * 1024;
constexpr size_t WE_DOWN = WE_UP + (size_t)4096 * 1024;
constexpr size_t WE_END = WE_DOWN + (size_t)1024 * 4096;
constexpr size_t WS_A = WS_W + WE_END * 2;
constexpr size_t WS_B1 = WS_A + (size_t)MP * 1024 * 2;
constexpr size_t WS_B2 = WS_B1 + (size_t)MP * LD1 * 2;
constexpr size_t WS_OA = WS_B2 + (size_t)MP * LD2 * 2;
constexpr size_t WS_D = WS_OA + (size_t)MP * 512 * 2;
constexpr size_t DUNIT = 36864;
constexpr size_t WS_BA = WS_D + (size_t)NUNIT_P * DUNIT * 2;
constexpr size_t WS_GL = WS_BA + (size_t)MP * 8 * 4;
constexpr size_t WS_ROPE = WS_GL + 2064 * 4 + 1024 - (2064 * 4) % 1024;
constexpr size_t WS_META = WS_ROPE + (size_t)8216 * 32 * 8;
constexpr size_t WS_BAR = WS_META + 64 * 1024 * 4;
constexpr size_t WS_END = WS_BAR + 16384;
constexpr size_t WS_HID = WS_B1;
constexpr size_t WS_M = WS_A;
static_assert((size_t)MP * 2048 * 2 <= (size_t)NUNIT_P * DUNIT * 2, "gates a,b must fit in D");
static_assert(WS_HID + (size_t)MP * 4096 * 2 <= WS_BA, "hid beyond D");
static_assert(WS_END <= (size_t)536870912, "ws too big");

struct Params {
  const float *x_prompt, *x_sample, *state_pool, *state_conv, *state_delta, *cache_k, *cache_v, *meta;
  const float *norm1_w, *w_in, *pool_w, *pool_scale, *conv_w, *a_log, *dt_bias, *onorm_w, *sinks;
  const float *proj_a, *proj_b, *proj_c, *w_out, *norm2_w, *w_up, *w_down, *final_w;
  float* out;
  char* ws;
};

__device__ __forceinline__ bfraw f2bf(float f) { return __builtin_bit_cast(bfraw, (__bf16)f); }
__device__ __forceinline__ float bf2f(bfraw h) { return __uint_as_float(((unsigned)h) << 16); }
typedef __bf16 bf16x2_t __attribute__((ext_vector_type(2)));
__device__ __forceinline__ unsigned pack2(float a, float b) { bf16x2_t v; v[0] = (__bf16)a; v[1] = (__bf16)b; return __builtin_bit_cast(unsigned, v); }
__device__ __forceinline__ float lo2f(unsigned u) { return __uint_as_float(u << 16); }
__device__ __forceinline__ float hi2f(unsigned u) { return __uint_as_float(u & 0xffff0000u); }
__device__ __forceinline__ int opq(int x) { asm volatile("" : "+v"(x)); return x; }
__device__ __forceinline__ float sigmoidf_(float x) { return __builtin_amdgcn_rcpf(1.f + __expf(-x)); }
__device__ __forceinline__ f32x4 mfma16(bf16x8 a, bf16x8 b, f32x4 c) {
  return __builtin_amdgcn_mfma_f32_16x16x32_bf16(a, b, c, 0, 0, 0);
}
__device__ __forceinline__ void unpack8(uint4 v, float* f) {
  f[0] = lo2f(v.x); f[1] = hi2f(v.x); f[2] = lo2f(v.y); f[3] = hi2f(v.y);
  f[4] = lo2f(v.z); f[5] = hi2f(v.z); f[6] = lo2f(v.w); f[7] = hi2f(v.w);
}
__device__ __forceinline__ uint4 pack8(const float* f) {
  uint4 v; v.x = pack2(f[0], f[1]); v.y = pack2(f[2], f[3]); v.z = pack2(f[4], f[5]); v.w = pack2(f[6], f[7]);
  return v;
}

#define LAS __attribute__((address_space(3)))
#define XB_TMO      128
#define XB_XCNT(j)  (256  + 64 * (j))
#define XB_XSUB(j)  (1280 + 64 * (j))
#define XB_XGEN(j)  (2304 + 64 * (j))
#define XB_TOP      3328
#define XB_TOPGEN   3392
#define XCD_BAR_WORDS 3456
#define XB_SPIN_CAP (1u << 18)

__device__ __forceinline__ unsigned xb_ld(unsigned* p)              { return __hip_atomic_load(p, __ATOMIC_RELAXED, __HIP_MEMORY_SCOPE_AGENT); }
__device__ __forceinline__ unsigned xb_add(unsigned* p, unsigned v) { return __hip_atomic_fetch_add(p, v, __ATOMIC_RELAXED, __HIP_MEMORY_SCOPE_AGENT); }
__device__ __forceinline__ unsigned xb_xcc_id() { return (unsigned)__builtin_amdgcn_s_getreg((3 << 11) | 20) & 0xFu; }
#define XB_SPIN(cond, bar) do { unsigned _sp = 0; while (cond) { __builtin_amdgcn_s_sleep(1); \
    if ((++_sp & 255u) == 0u) { if (xb_ld(&(bar)[XB_TMO])) break; if (_sp > XB_SPIN_CAP) { atomicAdd(&(bar)[XB_TMO], 1u); break; } } } } while (0)

struct XcdBarrier {
    unsigned* bar; unsigned x;
    volatile LAS unsigned* st;
};

__device__ __forceinline__ XcdBarrier xcd_barrier_post(unsigned* bar, volatile LAS unsigned* st) {
    XcdBarrier b; b.bar = bar; b.x = xb_xcc_id(); b.st = st;
    if (threadIdx.x == 0) (void)xb_add(&bar[XB_XCNT(b.x)], 1u);
    return b;
}
__device__ __forceinline__ void xcd_barrier_complete(unsigned* bar, unsigned x, unsigned& nloc, unsigned& nx) {
    const unsigned G = gridDim.x * gridDim.y * gridDim.z;
    unsigned sum, cnt, mine, sp = 0u;
    for (;;) {
        sum = 0u; cnt = 0u; mine = 0u;
#pragma unroll
        for (unsigned j = 0; j < 16; ++j) { const unsigned c = xb_ld(&bar[XB_XCNT(j)]); sum += c; cnt += (c > 0u) ? 1u : 0u; mine = (j == x) ? c : mine; }
        if (sum == G) break;
        __builtin_amdgcn_s_sleep(1);
        if ((++sp & 255u) == 0u) { if (xb_ld(&bar[XB_TMO])) break; if (sp > XB_SPIN_CAP) { atomicAdd(&bar[XB_TMO], 1u); break; } }
    }
    nloc = mine > 0u ? mine : 1u; nx = cnt > 0u ? cnt : 1u;
}

__device__ __forceinline__ void xcd_barrier(const XcdBarrier& b) {
    asm volatile("s_waitcnt vmcnt(0)" ::: "memory");
    __syncthreads();
    if (threadIdx.x == 0) {
        unsigned* bar = b.bar;
        __builtin_amdgcn_s_waitcnt(0);
        unsigned nloc = b.st[0], nx = b.st[1];
        if (nloc == 0u) { xcd_barrier_complete(bar, b.x, nloc, nx); b.st[0] = nloc; b.st[1] = nx; }
        const unsigned old = xb_add(&bar[XB_XSUB(b.x)], 1u);
        const unsigned gen = old / nloc;
        if (old + 1u == (gen + 1u) * nloc) {
            __builtin_amdgcn_fence(__ATOMIC_RELEASE, "agent");
            asm volatile("s_waitcnt vmcnt(0)" ::: "memory");
            const unsigned og = xb_add(&bar[XB_TOP], 1u);
            const unsigned tg = og / nx;
            if (og + 1u == (tg + 1u) * nx) xb_add(&bar[XB_TOPGEN], 1u);
            else XB_SPIN(xb_ld(&bar[XB_TOPGEN]) == tg, bar);
            __builtin_amdgcn_fence(__ATOMIC_ACQUIRE, "agent");
            xb_add(&bar[XB_XGEN(b.x)], 1u);
            asm volatile("s_waitcnt vmcnt(0)" ::: "memory");
        } else {
            XB_SPIN(xb_ld(&bar[XB_XGEN(b.x)]) == gen, bar);
            __builtin_amdgcn_fence(__ATOMIC_ACQUIRE, "agent");
            asm volatile("s_waitcnt vmcnt(0)" ::: "memory");
        }
    }
    __syncthreads();
}

__device__ __forceinline__ const float* xsrc0(const Params& p, int r) {
  if (r < ROWS_P) {
    int b = r / TP, t = r - b * TP;
    if (t < 16) return p.meta + (size_t)t * DM;
    return p.x_prompt + ((size_t)b * SEQ + (t - 16)) * DM;
  }
  return p.x_sample + (size_t)(r - ROWS_P) * DM;
}
__device__ __forceinline__ float* resid(const Params& p, int r) {
  if (r < ROWS_P) {
    int b = r / TP, t = r - b * TP;
    if (t < 16) return (float*)(p.ws + WS_META) + (size_t)(b * 16 + t) * DM;
    return p.out + O_YP + ((size_t)b * SEQ + (t - 16)) * DM;
  }
  return p.out + O_YS + (size_t)(r - ROWS_P) * DM;
}
__device__ __forceinline__ int posidx_of_row(int r) {
  if (r < ROWS_P) return r % TP;
  int s = r - ROWS_P;
  if (s >= NBS * TS) return 8215;
  return 8208 + (s & 7);
}

__device__ __forceinline__ void phase_tables(const Params& p) {
  const float invf[32] = {1.000000000e+00f, 7.498942614e-01f, 5.623413324e-01f, 4.216965139e-01f, 3.162277639e-01f, 2.371373773e-01f, 1.778279394e-01f, 1.333521307e-01f, 1.000000015e-01f, 7.498941571e-02f, 5.623413250e-02f, 4.216965288e-02f, 3.162277490e-02f, 2.371373773e-02f, 1.778279431e-02f, 1.333521493e-02f, 9.999999776e-03f, 7.498941850e-03f, 5.623413250e-03f, 4.216964822e-03f, 3.162277630e-03f, 2.371373586e-03f, 1.778279431e-03f, 1.333521446e-03f, 1.000000047e-03f, 7.498942432e-04f, 5.623413017e-04f, 4.216965172e-04f, 3.162277571e-04f, 2.371373703e-04f, 1.778279402e-04f, 1.333521504e-04f};
  float2* tab = (float2*)(p.ws + WS_ROPE);
  for (int i = blockIdx.x * NTHR + opq(threadIdx.x); i < 8216 * 32; i += gridDim.x * NTHR) {
    int pi = i >> 5, f = i & 31;
    int pos = pi < 8208 ? pi : 16384 + (pi - 8208);
    float fr = 1.0f;
#pragma unroll
    for (int k = 0; k < 32; ++k) if (k == f) fr = invf[k];
    float ang = (float)pos * fr;
    double x = (double)ang;
    double kq = rint(x * 0.63661977236758134308);
    double r = fma(-kq, 1.57079632679489655800e+00, x);
    r = fma(-kq, 6.12323399573676603587e-17, r);
    double r2 = r * r;
    double s = r * (1.0 + r2 * (-1.0 / 6 + r2 * (1.0 / 120 + r2 * (-1.0 / 5040 + r2 * (1.0 / 362880 + r2 * (-1.0 / 39916800 + r2 * (1.0 / 6227020800.0)))))));
    double c = 1.0 + r2 * (-0.5 + r2 * (1.0 / 24 + r2 * (-1.0 / 720 + r2 * (1.0 / 40320 + r2 * (-1.0 / 3628800 + r2 * (1.0 / 479001600.0))))));
    int qd = ((int)kq) & 3;
    double cs = (qd == 0) ? c : (qd == 1) ? -s : (qd == 2) ? -c : s;
    double sn = (qd == 0) ? s : (qd == 1) ? c : (qd == 2) ? -s : -c;
    tab[i] = make_float2((float)cs, (float)sn);
  }
}

__host__ __device__ __forceinline__ int perm32(int rho) { const int n = rho >> 4, i = rho & 15; return 8 * (i >> 2) + 4 * n + (i & 3); }
__device__ __forceinline__ int win_map(int s) {
  if (s >= NIN) { int lc = (s & ~31) + perm32(s & 31); return lc - NIN + 3336; }
  const int hb = s >> 6;
  int lc;
  if (hb >= 40 && hb < 50) { const int sg = s & 63; lc = hb * 64 + 16 * (sg >> 5) + (sg & 15) + 32 * ((sg >> 4) & 1); }
  else lc = (s & ~31) + perm32(s & 31);
  if (lc < 2560) return lc;
  if (lc < 3328) return lc + 8;
  if (lc < 3336) return 2560 + (lc - 3328);
  return -1;
}
__device__ __forceinline__ void conv_job(const float* __restrict__ src, int K, int ldsrc, bfraw* __restrict__ dst, int Ndst, int kind,
                         float* tile, int& tbase, const float* __restrict__ ksc) {
  const int tid = opq(threadIdx.x);
  int ntk = K / 64, ntn = Ndst / 64, nt = ntk * ntn;
  int first = (int)((blockIdx.x + gridDim.x - (tbase % gridDim.x)) % gridDim.x);
  for (int t = first; t < nt; t += 2 * gridDim.x) {
    const int t2 = t + gridDim.x;
    const bool has2 = t2 < nt;
    float va[8], vb[8];
    int tnA = t / ntk, tkA = t - tnA * ntk, tnB = 0, tkB = 0;
    {
      int n = tnA * 64 + (tid & 63);
      int sc = (kind == 1) ? win_map(n) : (kind == 2) ? ((n & ~31) + perm32(n & 31)) : n;
#pragma unroll
      for (int i = 0; i < 8; ++i) {
        int kl = (tid >> 6) + i * 8;
        float v = (sc >= 0) ? src[(size_t)(tkA * 64 + kl) * ldsrc + sc] : 0.f;
        if (ksc) v *= ksc[tkA * 64 + kl];
        va[i] = v;
      }
    }
    if (has2) {
      tnB = t2 / ntk; tkB = t2 - tnB * ntk;
      int n = tnB * 64 + (tid & 63);
      int sc = (kind == 1) ? win_map(n) : (kind == 2) ? ((n & ~31) + perm32(n & 31)) : n;
#pragma unroll
      for (int i = 0; i < 8; ++i) {
        int kl = (tid >> 6) + i * 8;
        float v = (sc >= 0) ? src[(size_t)(tkB * 64 + kl) * ldsrc + sc] : 0.f;
        if (ksc) v *= ksc[tkB * 64 + kl];
        vb[i] = v;
      }
    }
#pragma unroll
    for (int i = 0; i < 8; ++i) {
      int kl = (tid >> 6) + i * 8;
      tile[kl * 65 + (tid & 63)] = va[i];
      if (has2) tile[4160 + kl * 65 + (tid & 63)] = vb[i];
    }
    __syncthreads();
    {
      int nl = tid >> 3, kc = tid & 7;
      float f[8];
#pragma unroll
      for (int j = 0; j < 8; ++j) f[j] = tile[(kc * 8 + j) * 65 + nl];
      *(uint4*)(dst + (size_t)(tnA * 64 + nl) * K + tkA * 64 + kc * 8) = pack8(f);
      if (has2) {
#pragma unroll
        for (int j = 0; j < 8; ++j) f[j] = tile[4160 + (kc * 8 + j) * 65 + nl];
        *(uint4*)(dst + (size_t)(tnB * 64 + nl) * K + tkB * 64 + kc * 8) = pack8(f);
      }
    }
    __syncthreads();
  }
  tbase += nt;
}
__device__ __forceinline__ void phase_convert(const Params& p, int l, char* smem) {
  float* tile = (float*)smem;
  bfraw* W = (bfraw*)(p.ws + WS_W);
  int tb = 0;
  conv_job(p.w_up + (size_t)l * 1024 * 4096, 1024, 4096, W + WE_UP, 4096, 2, tile, tb, 0);
  conv_job(p.w_down + (size_t)l * 4096 * 1024, 4096, 1024, W + WE_DOWN, 1024, 0, tile, tb, 0);
  conv_job(p.w_in + (size_t)l * 1024 * D_IN, 1024, D_IN, W + WE_IN, NIN + 3072, 1, tile, tb, 0);
  conv_job(p.w_out + (size_t)l * 1024 * 1024, 1024, 1024, W + WE_OUT, 1024, 0, tile, tb, 0);
  conv_job(p.proj_a + (size_t)l * 512 * 1024, 512, 1024, W + WE_PA, 1024, 2, tile, tb, 0);
  conv_job(p.proj_b + (size_t)l * 512 * 1024, 512, 1024, W + WE_PB, 1024, 2, tile, tb, 0);
  conv_job(p.proj_c + (size_t)l * 512 * 1024, 512, 1024, W + WE_PC, 1024, 2, tile, tb, 0);
  for (int g = 0; g < 4; ++g)
    conv_job(p.pool_w + (size_t)(l * 4 + g) * 128 * 128, 128, 128, W + WE_POOL + g * 128 * 128, 128, 0, tile, tb, 0);
}

__device__ __forceinline__ void phase_final(const Params& p) {
  const int lane = opq(threadIdx.x) & 63, w = opq(threadIdx.x) >> 6;
  float4 wv[4];
#pragma unroll
  for (int j = 0; j < 4; ++j) wv[j] = *(const float4*)(p.final_w + j * 256 + lane * 4);
  for (int r = blockIdx.x * 8 + w; r < ROWS; r += gridDim.x * 8) {
    if (r < ROWS_P && (r % TP) < 16) continue;
    float* src = resid(p, r);
    float4 v[4];
    float ss = 0.f;
#pragma unroll
    for (int j = 0; j < 4; ++j) {
      v[j] = *(const float4*)(src + j * 256 + lane * 4);
      ss += v[j].x * v[j].x + v[j].y * v[j].y + v[j].z * v[j].z + v[j].w * v[j].w;
    }
#pragma unroll
    for (int o = 32; o >= 1; o >>= 1) ss += __shfl_xor(ss, o);
    float rinv = rsqrtf(ss * (1.f / 1024.f) + EPS);
#pragma unroll
    for (int j = 0; j < 4; ++j) {
      float4 o4 = make_float4(v[j].x * rinv * wv[j].x, v[j].y * rinv * wv[j].y, v[j].z * rinv * wv[j].z, v[j].w * rinv * wv[j].w);
      *(float4*)(src + j * 256 + lane * 4) = o4;
    }
  }
}

namespace g8 {
constexpr int BM = 256, BK = 64, HALF = 128, HTB = HALF * BK * 2, STAGE_BYTES = 8 * HTB, NXCD = 8, WGM = 8;
__device__ __forceinline__ int lds_byte(int r, int c) { const int st = (r >> 4) * 2 + (c >> 5), rr = r & 15, cc = c & 31, ob = rr * 64 + cc * 2; return st * 1024 + (ob ^ (((ob >> 9) & 1) << 5)); }
__device__ __forceinline__ void stage_rc(int b, int& R, int& C) { const int st = b / 1024, sb = b % 1024, swz = sb ^ (((sb >> 9) & 1) << 5); R = (st >> 1) * 16 + swz / 64; C = (st & 1) * 32 + (swz % 64) / 2; }
struct Unit { int pm, pn, koff, seq; };
struct Gemm { const bfraw* A; const bfraw* Bt; int M, N, K, lda, ldb; };
struct StaticOrder {
  int nM, nN, nwg, G, c, t0, cnt, ks, klen;
  __device__ void init(int M, int N, int G_, int c_) { nM = M / BM; nN = N / BM; nwg = nM * nN; G = G_; c = c_; t0 = 0; cnt = nwg; ks = 1; klen = 0; }
  __device__ void sub(int first, int ntiles, int ks_, int klen_) { t0 = first; cnt = ntiles * ks_; ks = ks_; klen = klen_; }
  __device__ bool next(int i, Unit& u) const {
    const long L = (long)i * G + c; if (L >= cnt) return false;
    int wgid = t0 + (int)L / ks; u.koff = ((int)L % ks) * klen; u.seq = (int)L;
    { const int q = nwg / NXCD, r = nwg % NXCD, xcd = wgid % NXCD, off = wgid / NXCD; wgid = (xcd < r ? xcd * (q + 1) : r * (q + 1) + (xcd - r) * q) + off; }
    const int nig = WGM * nN, gid = wgid / nig, fm = gid * WGM, gsz = (nM - fm) < WGM ? (nM - fm) : WGM;
    u.pm = fm + ((wgid % nig) % gsz); u.pn = (wgid % nig) / gsz; return true;
  }
};

struct GateOrder {
  int part, G, c;
  __device__ bool next(int i, Unit& u) const {
    const int L = i * G + c; u.koff = 0; u.seq = L;
    if (part == 0) { if (L >= 384) return false; u.pm = L / 3; u.pn = L - u.pm * 3; return true; }
    if (L >= 1212) return false;
    if (L < 1152) { u.pm = L / 9; u.pn = 3 + (L - u.pm * 9); }
    else { const int L2 = L - 1152; u.pm = 128 + L2 / 12; u.pn = L2 % 12; }
    return true;
  }
};

template <class Epi, class Sched>
__device__ __forceinline__ void gemm_phase(LAS unsigned char* lds, const Gemm g, const Sched& S, const Epi& E) {
  const int tid = opq(threadIdx.x), wid = __builtin_amdgcn_readfirstlane(tid >> 6), lane = tid & 63, wr = wid >> 2, wc = wid & 3, fr = lane & 15, fq = lane >> 4;
  const int K = g.K, nt = K / BK;
  unsigned voffA[2], voffB[2];
#pragma unroll
  for (int i = 0; i < 2; ++i) { int R, C; stage_rc(tid * 16 + i * 8192, R, C);
    voffA[i] = (unsigned)(R * g.lda + C) * 2u; voffB[i] = (unsigned)(R * g.ldb + C) * 2u; }
  const size_t kstep = (size_t)(BK * 2);
  const size_t hstepA = (size_t)HALF * g.lda * 2, hstepB = (size_t)HALF * g.ldb * 2;
  const size_t tstepA = 2 * hstepA, tstepB = 2 * hstepB;
  const unsigned ldsw = (unsigned)wid * 1024u;
  const int aoff = lds_byte(wr * 64 + fr, fq * 8), boff = lds_byte(wc * 32 + fr, fq * 8);
#define G8_SA(b, h) (((b) * 2 + (h)) * HTB)
#define G8_SB(b, h) ((4 + (b) * 2 + (h)) * HTB)
#define G8_STAGE(bufoff, gbase, voff) do { _Pragma("unroll") for (int _i = 0; _i < 2; ++_i) \
    __builtin_amdgcn_global_load_lds((const unsigned*)((const char*)(gbase) + (voff)[_i]), (LAS unsigned*)(lds + (bufoff) + ldsw + _i * 8192), 16, 0, 0); } while (0)
#define G8_LDA(dst, b, h) do { _Pragma("unroll") for (int m = 0; m < 4; ++m) _Pragma("unroll") for (int k = 0; k < 2; ++k) dst[m][k] = *(const LAS bf16x8*)(lds + G8_SA(b, h) + aoff + m * 2048 + k * 1024); } while (0)
#define G8_LDB(dst, b, h) do { _Pragma("unroll") for (int n = 0; n < 2; ++n) _Pragma("unroll") for (int k = 0; k < 2; ++k) dst[n][k] = *(const LAS bf16x8*)(lds + G8_SB(b, h) + boff + n * 2048 + k * 1024); } while (0)
#define G8_MMA(ai, bj, At, Bt) do { __builtin_amdgcn_s_setprio(1); _Pragma("unroll") for (int m = 0; m < 4; ++m) _Pragma("unroll") for (int n = 0; n < 2; ++n) _Pragma("unroll") for (int k = 0; k < 2; ++k) \
    acc[ai][bj][m][n] = __builtin_amdgcn_mfma_f32_16x16x32_bf16(Bt[n][k], At[m][k], acc[ai][bj][m][n], 0, 0, 0); __builtin_amdgcn_s_setprio(0); } while (0)
#define G8_WAIT_V(n) asm volatile("s_waitcnt vmcnt(" #n ")" ::: "memory")
#define G8_WAIT_L(n) asm volatile("s_waitcnt lgkmcnt(" #n ")" ::: "memory")
#define G8_BAR __builtin_amdgcn_s_barrier()
#define G8_SCHED __builtin_amdgcn_sched_barrier(0)
  Unit cur, nxt; int ui = 0;
  if (!S.next(0, cur)) return;
  f32x4 acc[2][2][4][2];
#pragma unroll
  for (int a = 0; a < 2; ++a)
#pragma unroll
    for (int b = 0; b < 2; ++b)
#pragma unroll
      for (int m = 0; m < 4; ++m)
#pragma unroll
        for (int n = 0; n < 2; ++n) acc[a][b][m][n] = (f32x4){0.f, 0.f, 0.f, 0.f};
  bf16x8 At[4][2], B0[2][2], B1[2][2];
  const char* cA = (const char*)g.A + (size_t)cur.pm * tstepA + (size_t)cur.koff * 2; const char* cB = (const char*)g.Bt + (size_t)cur.pn * tstepB + (size_t)cur.koff * 2;
  G8_STAGE(G8_SB(0, 0), cB, voffB); G8_STAGE(G8_SA(0, 0), cA, voffA); G8_STAGE(G8_SB(0, 1), cB + hstepB, voffB); G8_STAGE(G8_SA(0, 1), cA + hstepA, voffA);
  if (wr == 1) G8_BAR;
  G8_WAIT_V(4); G8_BAR;
  G8_STAGE(G8_SB(1, 0), cB + kstep, voffB); G8_STAGE(G8_SA(1, 0), cA + kstep, voffA); G8_STAGE(G8_SB(1, 1), cB + hstepB + kstep, voffB);
  G8_WAIT_V(6); G8_BAR;
  for (;;) {
    const bool has_next = S.next(ui + 1, nxt);
    const char* nA = has_next ? (const char*)g.A + (size_t)nxt.pm * tstepA + (size_t)nxt.koff * 2 : cA; const char* nB = has_next ? (const char*)g.Bt + (size_t)nxt.pn * tstepB + (size_t)nxt.koff * 2 : cB;
    for (int t = 0; t < nt; t += 2) {
      const bool last = (t == nt - 2);
      const char* a1 = cA + (size_t)(t + 1) * kstep;
      const char* a2 = last ? nA : cA + (size_t)(t + 2) * kstep; const char* b2 = last ? nB : cB + (size_t)(t + 2) * kstep;
      const char* a3 = a2 + kstep; const char* b3 = b2 + kstep;
      G8_LDB(B0, 0, 0); G8_SCHED; G8_LDA(At, 0, 0); G8_STAGE(G8_SA(1, 1), a1 + hstepA, voffA);
      G8_WAIT_L(8); G8_BAR; G8_WAIT_L(0); G8_MMA(0, 0, At, B0); G8_BAR; G8_SCHED;
      G8_LDB(B1, 0, 1); G8_STAGE(G8_SB(0, 0), b2, voffB);
      G8_BAR; G8_WAIT_L(0); G8_MMA(0, 1, At, B1); G8_BAR;
      G8_LDA(At, 0, 1); G8_STAGE(G8_SA(0, 0), a2, voffA);
      G8_BAR; G8_WAIT_L(0); G8_MMA(1, 0, At, B0); G8_BAR; G8_SCHED;
      G8_STAGE(G8_SB(0, 1), b2 + hstepB, voffB);
      G8_WAIT_V(6); G8_BAR; G8_MMA(1, 1, At, B1); G8_BAR;
      G8_LDB(B0, 1, 0); G8_SCHED; G8_LDA(At, 1, 0); G8_STAGE(G8_SA(0, 1), a2 + hstepA, voffA);
      G8_WAIT_L(8); G8_BAR; G8_WAIT_L(0); G8_MMA(0, 0, At, B0); G8_BAR; G8_SCHED;
      G8_LDB(B1, 1, 1); G8_STAGE(G8_SB(1, 0), b3, voffB);
      G8_BAR; G8_WAIT_L(0); G8_MMA(0, 1, At, B1); G8_BAR;
      G8_LDA(At, 1, 1); G8_STAGE(G8_SA(1, 0), a3, voffA);
      G8_BAR; G8_WAIT_L(0); G8_MMA(1, 0, At, B0); G8_BAR; G8_SCHED;
      G8_STAGE(G8_SB(1, 1), b3 + hstepB, voffB);
      G8_WAIT_V(6); G8_BAR; G8_MMA(1, 1, At, B1); G8_BAR;
    }
    E(acc, cur, wr, wc, fr, fq);
    if (!has_next) break;
#pragma unroll
    for (int a = 0; a < 2; ++a)
#pragma unroll
      for (int b = 0; b < 2; ++b)
#pragma unroll
        for (int m = 0; m < 4; ++m)
#pragma unroll
          for (int n = 0; n < 2; ++n) acc[a][b][m][n] = (f32x4){0.f, 0.f, 0.f, 0.f};
    cur = nxt; cA = nA; cB = nB; ++ui;
  }
  G8_WAIT_V(0);
  if (wr == 0) G8_BAR;
  G8_BAR;
#undef G8_SA
#undef G8_SB
#undef G8_STAGE
#undef G8_LDA
#undef G8_LDB
#undef G8_MMA
#undef G8_WAIT_V
#undef G8_WAIT_L
#undef G8_BAR
#undef G8_SCHED
}

struct Proj3 { const char* A[3]; int lda[3]; const char* B[3]; int ntiles; };
template <class Epi>
__device__ __forceinline__ void gemm_phase_proj(LAS unsigned char* lds, const Proj3 g, int G, int c, Epi& E) {
  const int tid = opq(threadIdx.x), wid = __builtin_amdgcn_readfirstlane(tid >> 6), lane = tid & 63, wr = wid >> 2, wc = wid & 3, fr = lane & 15, fq = lane >> 4;
  constexpr int K = 512, nt = K / BK, LDB = 512;
  StaticOrder SO; SO.init(MP, 1024, 1, 0);
  unsigned vA[3][2], voffB[2];
#pragma unroll
  for (int i = 0; i < 2; ++i) { int R, C; stage_rc(tid * 16 + i * 8192, R, C);
#pragma unroll
    for (int x = 0; x < 3; ++x) vA[x][i] = (unsigned)(R * g.lda[x] + C) * 2u;
    voffB[i] = (unsigned)(R * LDB + C) * 2u; }
  const size_t kstep = (size_t)(BK * 2);
  const size_t hstepB = (size_t)HALF * LDB * 2, tstepB = 2 * hstepB;
  const unsigned ldsw = (unsigned)wid * 1024u;
  const int aoff = lds_byte(wr * 64 + fr, fq * 8), boff = lds_byte(wc * 32 + fr, fq * 8);
#define G8_SA(b, h) (((b) * 2 + (h)) * HTB)
#define G8_SB(b, h) ((4 + (b) * 2 + (h)) * HTB)
#define G8_STAGE(bufoff, gbase, voff) do { _Pragma("unroll") for (int _i = 0; _i < 2; ++_i) \
    __builtin_amdgcn_global_load_lds((const unsigned*)((const char*)(gbase) + (voff)[_i]), (LAS unsigned*)(lds + (bufoff) + ldsw + _i * 8192), 16, 0, 0); } while (0)
#define G8_LDA(dst, b, h) do { _Pragma("unroll") for (int m = 0; m < 4; ++m) _Pragma("unroll") for (int k = 0; k < 2; ++k) dst[m][k] = *(const LAS bf16x8*)(lds + G8_SA(b, h) + aoff + m * 2048 + k * 1024); } while (0)
#define G8_LDB(dst, b, h) do { _Pragma("unroll") for (int n = 0; n < 2; ++n) _Pragma("unroll") for (int k = 0; k < 2; ++k) dst[n][k] = *(const LAS bf16x8*)(lds + G8_SB(b, h) + boff + n * 2048 + k * 1024); } while (0)
#define G8_MMA(ai, bj, At, Bt) do { __builtin_amdgcn_s_setprio(1); _Pragma("unroll") for (int m = 0; m < 4; ++m) _Pragma("unroll") for (int n = 0; n < 2; ++n) _Pragma("unroll") for (int k = 0; k < 2; ++k) \
    acc[ai][bj][m][n] = __builtin_amdgcn_mfma_f32_16x16x32_bf16(Bt[n][k], At[m][k], acc[ai][bj][m][n], 0, 0, 0); __builtin_amdgcn_s_setprio(0); } while (0)
#define G8_WAIT_V(n) asm volatile("s_waitcnt vmcnt(" #n ")" ::: "memory")
#define G8_WAIT_L(n) asm volatile("s_waitcnt lgkmcnt(" #n ")" ::: "memory")
#define G8_BAR __builtin_amdgcn_s_barrier()
#define G8_SCHED __builtin_amdgcn_sched_barrier(0)
#define PJ_UNIT(i, u, x, ok) { const int tl_ = ((i) / 3) * G + c; ok = tl_ < g.ntiles; x = (i) % 3; if (ok) SO.next(tl_, u); }
#define PJ_SEL(dst, x) { dst[0] = (x) == 0 ? vA[0][0] : (x) == 1 ? vA[1][0] : vA[2][0]; dst[1] = (x) == 0 ? vA[0][1] : (x) == 1 ? vA[1][1] : vA[2][1]; }
#define PJ_LDA(x) ((x) == 0 ? g.lda[0] : (x) == 1 ? g.lda[1] : g.lda[2])
#define PJ_ABASE(x) ((x) == 0 ? g.A[0] : (x) == 1 ? g.A[1] : g.A[2])
#define PJ_BBASE(x) ((x) == 0 ? g.B[0] : (x) == 1 ? g.B[1] : g.B[2])
  Unit cur, nxt; int cx, nx = 0, ui = 0; bool ok;
  PJ_UNIT(0, cur, cx, ok)
  if (!ok) return;
  f32x4 acc[2][2][4][2];
#pragma unroll
  for (int a = 0; a < 2; ++a)
#pragma unroll
    for (int b = 0; b < 2; ++b)
#pragma unroll
      for (int m = 0; m < 4; ++m)
#pragma unroll
        for (int n = 0; n < 2; ++n) acc[a][b][m][n] = (f32x4){0.f, 0.f, 0.f, 0.f};
  bf16x8 At[4][2], B0[2][2], B1[2][2];
  unsigned voC[2], voN[2];
  PJ_SEL(voC, cx)
  size_t hC = (size_t)HALF * PJ_LDA(cx) * 2, hN = hC;
  const char* cA = PJ_ABASE(cx) + (size_t)cur.pm * 2 * hC; const char* cB = PJ_BBASE(cx) + (size_t)cur.pn * tstepB;
  G8_STAGE(G8_SB(0, 0), cB, voffB); G8_STAGE(G8_SA(0, 0), cA, voC); G8_STAGE(G8_SB(0, 1), cB + hstepB, voffB); G8_STAGE(G8_SA(0, 1), cA + hC, voC);
  if (wr == 1) G8_BAR;
  G8_WAIT_V(4); G8_BAR;
  G8_STAGE(G8_SB(1, 0), cB + kstep, voffB); G8_STAGE(G8_SA(1, 0), cA + kstep, voC); G8_STAGE(G8_SB(1, 1), cB + hstepB + kstep, voffB);
  G8_WAIT_V(6); G8_BAR;
  for (;;) {
    bool has_next; PJ_UNIT(ui + 1, nxt, nx, has_next)
    const char* nA = cA; const char* nB = cB; voN[0] = voC[0]; voN[1] = voC[1]; hN = hC;
    if (has_next) { PJ_SEL(voN, nx) hN = (size_t)HALF * PJ_LDA(nx) * 2; nA = PJ_ABASE(nx) + (size_t)nxt.pm * 2 * hN; nB = PJ_BBASE(nx) + (size_t)nxt.pn * tstepB; }
    for (int t = 0; t < nt; t += 2) {
      const bool last = (t == nt - 2);
      const char* a1 = cA + (size_t)(t + 1) * kstep;
      const char* a2 = last ? nA : cA + (size_t)(t + 2) * kstep; const char* b2 = last ? nB : cB + (size_t)(t + 2) * kstep;
      const char* a3 = a2 + kstep; const char* b3 = b2 + kstep;
      unsigned vo2[2]; vo2[0] = last ? voN[0] : voC[0]; vo2[1] = last ? voN[1] : voC[1];
      const size_t h2 = last ? hN : hC;
      G8_LDB(B0, 0, 0); G8_SCHED; G8_LDA(At, 0, 0); G8_STAGE(G8_SA(1, 1), a1 + hC, voC);
      G8_WAIT_L(8); G8_BAR; G8_WAIT_L(0); G8_MMA(0, 0, At, B0); G8_BAR; G8_SCHED;
      G8_LDB(B1, 0, 1); G8_STAGE(G8_SB(0, 0), b2, voffB);
      G8_BAR; G8_WAIT_L(0); G8_MMA(0, 1, At, B1); G8_BAR;
      G8_LDA(At, 0, 1); G8_STAGE(G8_SA(0, 0), a2, vo2);
      G8_BAR; G8_WAIT_L(0); G8_MMA(1, 0, At, B0); G8_BAR; G8_SCHED;
      G8_STAGE(G8_SB(0, 1), b2 + hstepB, voffB);
      G8_WAIT_V(6); G8_BAR; G8_MMA(1, 1, At, B1); G8_BAR;
      G8_LDB(B0, 1, 0); G8_SCHED; G8_LDA(At, 1, 0); G8_STAGE(G8_SA(0, 1), a2 + h2, vo2);
      G8_WAIT_L(8); G8_BAR; G8_WAIT_L(0); G8_MMA(0, 0, At, B0); G8_BAR; G8_SCHED;
      G8_LDB(B1, 1, 1); G8_STAGE(G8_SB(1, 0), b3, voffB);
      G8_BAR; G8_WAIT_L(0); G8_MMA(0, 1, At, B1); G8_BAR;
      G8_LDA(At, 1, 1); G8_STAGE(G8_SA(1, 0), a3, vo2);
      G8_BAR; G8_WAIT_L(0); G8_MMA(1, 0, At, B0); G8_BAR; G8_SCHED;
      G8_STAGE(G8_SB(1, 1), b3 + hstepB, voffB);
      G8_WAIT_V(6); G8_BAR; G8_MMA(1, 1, At, B1); G8_BAR;
    }
    E(acc, cur, cx, wr, wc, fr, fq);
    if (!has_next) break;
    if (cx == 2) {
#pragma unroll
      for (int a = 0; a < 2; ++a)
#pragma unroll
        for (int b = 0; b < 2; ++b)
#pragma unroll
          for (int m = 0; m < 4; ++m)
#pragma unroll
            for (int n = 0; n < 2; ++n) acc[a][b][m][n] = (f32x4){0.f, 0.f, 0.f, 0.f};
    }
    cur = nxt; cx = nx; cA = nA; cB = nB; voC[0] = voN[0]; voC[1] = voN[1]; hC = hN; ++ui;
  }
  G8_WAIT_V(0);
  if (wr == 0) G8_BAR;
  G8_BAR;
#undef G8_SA
#undef G8_SB
#undef G8_STAGE
#undef G8_LDA
#undef G8_LDB
#undef G8_MMA
#undef G8_WAIT_V
#undef G8_WAIT_L
#undef G8_BAR
#undef G8_SCHED
#undef PJ_UNIT
#undef PJ_SEL
#undef PJ_LDA
#undef PJ_ABASE
#undef PJ_BBASE
}
}

__device__ __forceinline__ void phase_norm(const Params& p, int mode, const float* __restrict__ nw, const float* __restrict__ wba,
                                           int tail_l = -1, char* sm = nullptr) {
  const int lane = opq(threadIdx.x) & 63, w = opq(threadIdx.x) >> 6;
  signed char* tt = (signed char*)sm;
  if (tail_l >= 0) {
    for (int i = opq(threadIdx.x); i < 133 * 4; i += NTHR) tt[i] = -1;
    __syncthreads();
    if (opq(threadIdx.x) < 20) {
      g8::StaticOrder S; S.init(MP, 1024, 1, 0); S.sub(512, 20, 1, 0);
      g8::Unit u; S.next(opq(threadIdx.x), u);
      tt[u.pm * 4 + u.pn] = (signed char)opq(threadIdx.x);
    }
    __syncthreads();
  }
  const float* PSo = (const float*)(p.ws + WS_D);
  bfraw* A = (bfraw*)(p.ws + WS_A);
  float* BA = (float*)(p.ws + WS_BA);
  float4 wv[4];
#pragma unroll
  for (int j = 0; j < 4; ++j) wv[j] = *(const float4*)(nw + j * 256 + lane * 4);
  float wq[16][8];
  if (wba) {
#pragma unroll
    for (int j = 0; j < 4; ++j)
#pragma unroll
      for (int e = 0; e < 4; ++e) {
        const int k = j * 256 + lane * 4 + e;
        const float nwk = (e == 0) ? wv[j].x : (e == 1) ? wv[j].y : (e == 2) ? wv[j].z : wv[j].w;
        const float4 a = *(const float4*)(wba + (size_t)k * D_IN), b = *(const float4*)(wba + (size_t)k * D_IN + 4);
        wq[j * 4 + e][0] = a.x * nwk; wq[j * 4 + e][1] = a.y * nwk; wq[j * 4 + e][2] = a.z * nwk; wq[j * 4 + e][3] = a.w * nwk;
        wq[j * 4 + e][4] = b.x * nwk; wq[j * 4 + e][5] = b.y * nwk; wq[j * 4 + e][6] = b.z * nwk; wq[j * 4 + e][7] = b.w * nwk;
      }
  }
  for (int r = blockIdx.x * 8 + w; r < MP; r += gridDim.x * 8) {
    bfraw* dst = A + (size_t)r * DM;
    if (r >= ROWS) {
#pragma unroll
      for (int j = 0; j < 4; ++j) *(uint2*)(dst + j * 256 + lane * 4) = make_uint2(0u, 0u);
      continue;
    }
    const float* src = mode ? (const float*)resid(p, r) : xsrc0(p, r);
    float4 v[4];
    float ss = 0.f;
#pragma unroll
    for (int j = 0; j < 4; ++j) {
      v[j] = *(const float4*)(src + j * 256 + lane * 4);
      if (tail_l >= 0) {
        const int t = tt[(r >> 8) * 4 + j];
        if (t >= 0) {
          if (tail_l == 0) v[j] = *(const float4*)(xsrc0(p, r) + j * 256 + lane * 4);
#pragma unroll
          for (int k = 0; k < 4; ++k) {
            const float4 a = *(const float4*)(PSo + (size_t)(t * 4 + k) * 65536 + (r & 255) * 256 + lane * 4);
            v[j].x += a.x; v[j].y += a.y; v[j].z += a.z; v[j].w += a.w;
          }
          *(float4*)(resid(p, r) + j * 256 + lane * 4) = v[j];
        }
      }
      ss += v[j].x * v[j].x + v[j].y * v[j].y + v[j].z * v[j].z + v[j].w * v[j].w;
    }
#pragma unroll
    for (int o = 32; o >= 1; o >>= 1) ss += __shfl_xor(ss, o);
    float rinv = rsqrtf(ss * (1.f / 1024.f) + EPS);
#pragma unroll
    for (int j = 0; j < 4; ++j) {
      uint2 o2;
      o2.x = pack2(v[j].x * rinv * wv[j].x, v[j].y * rinv * wv[j].y);
      o2.y = pack2(v[j].z * rinv * wv[j].z, v[j].w * rinv * wv[j].w);
      *(uint2*)(dst + j * 256 + lane * 4) = o2;
    }
    if (wba) {
      float d[8];
#pragma unroll
      for (int c = 0; c < 8; ++c) {
        float s = 0.f;
#pragma unroll
        for (int j = 0; j < 4; ++j)
          s += v[j].x * wq[j * 4 + 0][c] + v[j].y * wq[j * 4 + 1][c] + v[j].z * wq[j * 4 + 2][c] + v[j].w * wq[j * 4 + 3][c];
#pragma unroll
        for (int o = 32; o >= 1; o >>= 1) s += __shfl_xor(s, o);
        d[c] = s * rinv;
      }
      if (lane == 0) {
        *(float4*)(BA + (size_t)r * 8) = make_float4(d[0], d[1], d[2], d[3]);
        *(float4*)(BA + (size_t)r * 8 + 4) = make_float4(d[4], d[5], d[6], d[7]);
      }
    }
  }
}
__device__ __forceinline__ uint4 pack8v(f32x4 a, f32x4 b) {
  uint4 v; v.x = pack2(a[0], a[1]); v.y = pack2(a[2], a[3]); v.z = pack2(b[0], b[1]); v.w = pack2(b[2], b[3]); return v;
}

struct EpiP1 {
  bfraw* B1; bfraw* B2; float* BA; const float2* tab;
  __device__ __forceinline__ void operator()(const f32x4 (&acc)[2][2][4][2], const g8::Unit& u, int wr, int wc, int fr, int fq) const {
    const int pn = u.pn;
#pragma unroll
    for (int ai = 0; ai < 2; ++ai)
#pragma unroll
      for (int m = 0; m < 4; ++m) {
        const int row = u.pm * 256 + ai * 128 + wr * 64 + m * 16 + fr;
        int pi = 0;
        if (pn >= 10 && pn <= 12) pi = posidx_of_row(row);
#pragma unroll
        for (int bj = 0; bj < 2; ++bj) {
          const f32x4 v0 = acc[ai][bj][m][0], v1 = acc[ai][bj][m][1];
          const int lc0 = pn * 256 + bj * 128 + wc * 32;
          if (pn < 8) {
            *(uint4*)(B1 + (size_t)row * LD1 + lc0 + 8 * fq) = pack8v(v0, v1);
          } else if (pn < 10 || (pn == 12 && bj == 1)) {
            *(uint4*)(B2 + (size_t)row * LD2 + (lc0 - 2048) + 8 * fq) = pack8v(v0, v1);
          } else if (pn < 13) {
            const int hb = lc0 & ~63;
            const int d0 = 16 * (wc & 1) + 4 * fq;
            const float sc = (pn < 12) ? 0.125f : 1.0f;
            float o1[4], o2[4];
#pragma unroll
            for (int j = 0; j < 4; ++j) {
              const float2 cs = tab[pi * 32 + d0 + j];
              o1[j] = (v0[j] * cs.x - v1[j] * cs.y) * sc;
              o2[j] = (v1[j] * cs.x + v0[j] * cs.y) * sc;
            }
            uint2 w1, w2;
            w1.x = pack2(o1[0], o1[1]); w1.y = pack2(o1[2], o1[3]);
            w2.x = pack2(o2[0], o2[1]); w2.y = pack2(o2[2], o2[3]);
            bfraw* dst = B2 + (size_t)row * LD2 + (hb - 2048) + d0;
            *(uint2*)dst = w1;
            *(uint2*)(dst + 32) = w2;
          } else {
            if (bj == 0 && wc == 0 && fq == 0) {
              *(f32x4*)(BA + (size_t)row * 8) = v0;
              *(f32x4*)(BA + (size_t)row * 8 + 4) = v1;
            }
          }
        }
      }
  }
};
template <int ACT> struct EpiAct {
  bfraw* O0; bfraw* O1; int ldc; int split;
  __device__ __forceinline__ void operator()(const f32x4 (&acc)[2][2][4][2], const g8::Unit& u, int wr, int wc, int fr, int fq) const {
#pragma unroll
    for (int ai = 0; ai < 2; ++ai)
#pragma unroll
      for (int m = 0; m < 4; ++m) {
        const int row = u.pm * 256 + ai * 128 + wr * 64 + m * 16 + fr;
#pragma unroll
        for (int bj = 0; bj < 2; ++bj) {
          f32x4 v0 = acc[ai][bj][m][0], v1 = acc[ai][bj][m][1];
#pragma unroll
          for (int j = 0; j < 4; ++j) {
            if (ACT == 1) { v0[j] = sigmoidf_(v0[j]); v1[j] = sigmoidf_(v1[j]); }
            else { float a = fmaxf(v0[j], 0.f), b = fmaxf(v1[j], 0.f); v0[j] = a * a; v1[j] = b * b; }
          }
          const int c = u.pn * 256 + bj * 128 + wc * 32 + 8 * fq;
          bfraw* dst = (c < split) ? (O0 + (size_t)row * ldc + c) : (O1 + (size_t)row * ldc + (c - split));
          *(uint4*)dst = pack8v(v0, v1);
        }
      }
  }
};
struct EpiProj {
  bfraw* M; const bfraw* G0; const bfraw* G1; int csplit; int first;
  __device__ __forceinline__ void operator()(const f32x4 (&acc)[2][2][4][2], const g8::Unit& u, int wr, int wc, int fr, int fq) const {
#pragma unroll
    for (int ai = 0; ai < 2; ++ai)
#pragma unroll
      for (int m = 0; m < 4; ++m) {
        const int row = u.pm * 256 + ai * 128 + wr * 64 + m * 16 + fr;
#pragma unroll
        for (int bj = 0; bj < 2; ++bj) {
          const int c = u.pn * 256 + bj * 128 + wc * 32 + 8 * fq;
          const bfraw* G = (c < csplit) ? G0 : G1;
          float gv[8], mv[8];
          unpack8(*(const uint4*)(G + (size_t)row * 2048 + c), gv);
          if (!first) unpack8(*(const uint4*)(M + (size_t)row * DM + c), mv);
          else {
#pragma unroll
            for (int j = 0; j < 8; ++j) mv[j] = 0.f;
          }
          const f32x4 v0 = acc[ai][bj][m][0], v1 = acc[ai][bj][m][1];
#pragma unroll
          for (int j = 0; j < 4; ++j) { mv[j] += gv[j] * v0[j]; mv[4 + j] += gv[4 + j] * v1[j]; }
          *(uint4*)(M + (size_t)row * DM + c) = pack8(mv);
        }
      }
  }
};
struct EpiResid {
  const Params* p; int from_input; int atomic;
  __device__ __forceinline__ void operator()(const f32x4 (&acc)[2][2][4][2], const g8::Unit& u, int wr, int wc, int fr, int fq) const {
#pragma unroll
    for (int ai = 0; ai < 2; ++ai)
#pragma unroll
      for (int m = 0; m < 4; ++m) {
        const int row = u.pm * 256 + ai * 128 + wr * 64 + m * 16 + fr;
        if (row < ROWS) {
          float* xd = resid(*p, row);
          const float* xs = from_input ? xsrc0(*p, row) : (const float*)xd;
#pragma unroll
          for (int bj = 0; bj < 2; ++bj)
#pragma unroll
            for (int n = 0; n < 2; ++n) {
              const int c = u.pn * 256 + bj * 128 + wc * 32 + 16 * n + 4 * fq;
              if (atomic) {
#pragma unroll
                for (int j = 0; j < 4; ++j) unsafeAtomicAdd(xd + c + j, acc[ai][bj][m][n][j]);
              } else {
                f32x4 x = *(const f32x4*)(xs + c);
                *(f32x4*)(xd + c) = x + acc[ai][bj][m][n];
              }
            }
        }
      }
  }
};

struct EpiPart {
  float* PS; int tile0; int ks;
  __device__ __forceinline__ void operator()(const f32x4 (&acc)[2][2][4][2], const g8::Unit& u, int wr, int wc, int fr, int fq) const {
    float* base = PS + (size_t)(u.seq) * 65536;
#pragma unroll
    for (int ai = 0; ai < 2; ++ai)
#pragma unroll
      for (int m = 0; m < 4; ++m) {
        const int rl = ai * 128 + wr * 64 + m * 16 + fr;
#pragma unroll
        for (int bj = 0; bj < 2; ++bj)
#pragma unroll
          for (int n = 0; n < 2; ++n) {
            const int c = bj * 128 + wc * 32 + 16 * n + 4 * fq;
            *(f32x4*)(base + rl * 256 + c) = acc[ai][bj][m][n];
          }
      }
  }
};
__device__ __forceinline__ void phase_p1(const Params& p, char* sm) {
  g8::Gemm g{(const bfraw*)(p.ws + WS_A), (const bfraw*)(p.ws + WS_W) + WE_IN, MP, NIN, DM, DM, DM};
  g8::StaticOrder S; S.init(MP, NIN, gridDim.x, blockIdx.x);
  EpiP1 E{(bfraw*)(p.ws + WS_B1), (bfraw*)(p.ws + WS_B2), (float*)(p.ws + WS_BA), (const float2*)(p.ws + WS_ROPE)};
  g8::gemm_phase(( LAS unsigned char*)sm, g, S, E);
}
__device__ __forceinline__ void phase_gate(const Params& p, char* sm, int part, int G, int c) {
  g8::Gemm g{(const bfraw*)(p.ws + WS_A), (const bfraw*)(p.ws + WS_W) + WE_IN + (size_t)NIN * DM, MP, 3072, DM, DM, DM};
  g8::GateOrder S{part, G, c};
  EpiAct<1> E{(bfraw*)(p.ws + WS_B1) + 512, (bfraw*)(p.ws + WS_D), 2048, 1536};
  g8::gemm_phase((LAS unsigned char*)sm, g, S, E);
}
struct EpiProjH {
  bfraw* M; const bfraw* GB; const bfraw* GD;
  __device__ __forceinline__ const bfraw* gp(int row, int gcol) const {
    return (gcol < 1536) ? GB + (size_t)row * 2048 + gcol : GD + (size_t)row * 2048 + (gcol - 1536);
  }
  __device__ __forceinline__ void operator()(f32x4 (&acc)[2][2][4][2], const g8::Unit& u, int x, int wr, int wc, int fr, int fq) const {
#pragma unroll
    for (int ai = 0; ai < 2; ++ai)
#pragma unroll
      for (int m = 0; m < 4; ++m) {
        const int row = u.pm * 256 + ai * 128 + wr * 64 + m * 16 + fr;
#pragma unroll
        for (int bj = 0; bj < 2; ++bj) {
          const int c = u.pn * 256 + bj * 128 + wc * 32 + 8 * fq;
          float sc[8];
          if (x < 2) {
            float g0[8], g1[8];
            unpack8(*(const uint4*)gp(row, x * 1024 + c), g0);
            unpack8(*(const uint4*)gp(row, (x + 1) * 1024 + c), g1);
#pragma unroll
            for (int j = 0; j < 8; ++j) sc[j] = g0[j] * __builtin_amdgcn_rcpf(fmaxf(g1[j], 1e-20f));
          } else {
            unpack8(*(const uint4*)gp(row, 2048 + c), sc);
          }
#pragma unroll
          for (int j = 0; j < 4; ++j) { acc[ai][bj][m][0][j] *= sc[j]; acc[ai][bj][m][1][j] *= sc[4 + j]; }
          if (x == 2) *(uint4*)(M + (size_t)row * DM + c) = pack8v(acc[ai][bj][m][0], acc[ai][bj][m][1]);
        }
      }
  }
};
__device__ __forceinline__ void phase_proj(const Params& p, char* sm) {
  const bfraw* W = (const bfraw*)(p.ws + WS_W);
  g8::Proj3 g;
  g.A[0] = (const char*)(p.ws + WS_OA); g.lda[0] = 512; g.B[0] = (const char*)(W + WE_PA);
  g.A[1] = (const char*)(p.ws + WS_B1); g.lda[1] = LD1; g.B[1] = (const char*)(W + WE_PB);
  g.A[2] = (const char*)((const bfraw*)(p.ws + WS_B2) + 512); g.lda[2] = LD2; g.B[2] = (const char*)(W + WE_PC);
  g.ntiles = 532;
  EpiProjH E{(bfraw*)(p.ws + WS_M), (const bfraw*)(p.ws + WS_B1) + 512, (const bfraw*)(p.ws + WS_D)};
  g8::gemm_phase_proj((LAS unsigned char*)sm, g, gridDim.x, blockIdx.x, E);
}
constexpr int OUT_FULL = 512, OUT_TAIL = 20, OUT_KS = 4;
__device__ __forceinline__ void phase_out(const Params& p, int l, char* sm) {
  {
    g8::Gemm g{(const bfraw*)(p.ws + WS_M), (const bfraw*)(p.ws + WS_W) + WE_OUT, MP, 1024, DM, DM, DM};
    g8::StaticOrder S; S.init(MP, 1024, gridDim.x, blockIdx.x); S.sub(0, OUT_FULL, 1, 0);
    EpiResid E{&p, l == 0 ? 1 : 0, 0};
    g8::gemm_phase((LAS unsigned char*)sm, g, S, E);
  }
  {
    g8::Gemm g{(const bfraw*)(p.ws + WS_M), (const bfraw*)(p.ws + WS_W) + WE_OUT, MP, 1024, DM / OUT_KS, DM, DM};
    g8::StaticOrder S; S.init(MP, 1024, gridDim.x, blockIdx.x); S.sub(OUT_FULL, OUT_TAIL, OUT_KS, DM / OUT_KS);
    EpiPart E{(float*)(p.ws + WS_D), OUT_FULL, OUT_KS};
    g8::gemm_phase((LAS unsigned char*)sm, g, S, E);
  }
}
__device__ __forceinline__ void phase_up(const Params& p, char* sm) {
  g8::Gemm g{(const bfraw*)(p.ws + WS_A), (const bfraw*)(p.ws + WS_W) + WE_UP, MP, DFF, DM, DM, DM};
  g8::StaticOrder S; S.init(MP, DFF, gridDim.x, blockIdx.x);
  EpiAct<2> E{(bfraw*)(p.ws + WS_HID), (bfraw*)(p.ws + WS_HID), DFF, 1 << 30};
  g8::gemm_phase((LAS unsigned char*)sm, g, S, E);
}
constexpr int DOWN_FULL = 512, DOWN_TAIL = 20, DOWN_KS = 8;
__device__ __forceinline__ void phase_down(const Params& p, char* sm) {
  {
    g8::Gemm g{(const bfraw*)(p.ws + WS_HID), (const bfraw*)(p.ws + WS_W) + WE_DOWN, MP, 1024, DFF, DFF, DFF};
    g8::StaticOrder S; S.init(MP, 1024, gridDim.x, blockIdx.x); S.sub(0, DOWN_FULL, 1, 0);
    EpiResid E{&p, 0, 0};
    g8::gemm_phase((LAS unsigned char*)sm, g, S, E);
  }
  {
    g8::Gemm g{(const bfraw*)(p.ws + WS_HID), (const bfraw*)(p.ws + WS_W) + WE_DOWN, MP, 1024, DFF / DOWN_KS, DFF, DFF};
    g8::StaticOrder S; S.init(MP, 1024, gridDim.x, blockIdx.x); S.sub(DOWN_FULL, DOWN_TAIL, DOWN_KS, DFF / DOWN_KS);
    EpiPart E{(float*)(p.ws + WS_A), DOWN_FULL, DOWN_KS};
    g8::gemm_phase((LAS unsigned char*)sm, g, S, E);
  }
}
__device__ __forceinline__ void down_reduce(const Params& p) {
  const float* PS = (const float*)(p.ws + WS_A);
  g8::StaticOrder S; S.init(MP, 1024, 1, 0); S.sub(DOWN_FULL, DOWN_TAIL, 1, 0);
  for (int i = blockIdx.x * NTHR + opq(threadIdx.x); i < DOWN_TAIL * 16384; i += gridDim.x * NTHR) {
    const int t = i >> 14, e = i & 16383, rl = e >> 6, c4 = (e & 63) * 4;
    g8::Unit u; S.next(t, u);
    const int row = u.pm * 256 + rl;
    if (row >= ROWS) continue;
    f32x4 s = (f32x4){0.f, 0.f, 0.f, 0.f};
#pragma unroll
    for (int k = 0; k < DOWN_KS; ++k) s += *(const f32x4*)(PS + (size_t)(t * DOWN_KS + k) * 65536 + rl * 256 + c4);
    float* xd = resid(p, row) + u.pn * 256 + c4;
    *(f32x4*)xd = *(const f32x4*)xd + s;
  }
}

__device__ __forceinline__ void pool_item(const Params& p, int l, int it, char* smem_c) {
  const int tid = opq(threadIdx.x), lane = tid & 63, w = tid >> 6, r = lane & 15, q = lane >> 4;
  bfraw* dA = (bfraw*)smem_c;
  bfraw* sW = (bfraw*)(smem_c + 64 * 136 * 2);
  bfraw* U = (bfraw*)(smem_c + 52224);
  const bfraw* B1 = (const bfraw*)(p.ws + WS_B1);
  bfraw* OA = (bfraw*)(p.ws + WS_OA);
  const int rt = it >> 2, g = it & 3;
  int grow0, nrows, t0 = 0;
  const bool isP = rt < NBP * NCH;
  if (isP) { int b = rt / NCH, i = rt - b * NCH; t0 = i * 64; nrows = min(64, TP - t0); grow0 = b * TP + t0; }
  else { grow0 = ROWS_P + (rt - NBP * NCH) * 64; nrows = 64; }
  const int wnd = 2 << g;
  {
    uint4 sv[6];
    const int nch = isP ? 79 * 16 : 184 * 16;
#pragma unroll
    for (int i = 0; i < 6; ++i) {
      const int c = tid + i * NTHR;
      uint4 v = make_uint4(0u, 0u, 0u, 0u);
      if (c < nch) {
        const int rr = c >> 4, ch = c & 15;
        if (isP) {
          const int t = t0 - 15 + rr;
          if (t >= 0 && t < TP) v = *(const uint4*)(B1 + (size_t)(grow0 - 15 + rr) * LD1 + g * 128 + ch * 8);
        } else {
          const int sg = rr / 23, pp = rr - sg * 23;
          const int bb = ((grow0 - ROWS_P) >> 3) + sg;
          if (pp < 15) {
            const float* s = p.state_pool + ((size_t)(l * NBS + bb) * 15 + pp) * 512 + g * 128 + ch * 8;
            float4 f0 = *(const float4*)s, f1 = *(const float4*)(s + 4);
            v.x = pack2(f0.x, f0.y); v.y = pack2(f0.z, f0.w); v.z = pack2(f1.x, f1.y); v.w = pack2(f1.z, f1.w);
          } else v = *(const uint4*)(B1 + (size_t)(ROWS_P + bb * TS + pp - 15) * LD1 + g * 128 + ch * 8);
        }
      }
      sv[i] = v;
    }
#pragma unroll
    for (int i = 0; i < 6; ++i) {
      const int c = tid + i * NTHR;
      if (c < nch) *(uint4*)(U + (c >> 4) * 136 + (c & 15) * 8) = sv[i];
    }
    const bfraw* Wp = (const bfraw*)(p.ws + WS_W) + WE_POOL + g * 128 * 128;
    uint4 wv4[4];
#pragma unroll
    for (int i = 0; i < 4; ++i) { int c = tid + i * 512; wv4[i] = *(const uint4*)(Wp + (c >> 4) * 128 + (c & 15) * 8); }
#pragma unroll
    for (int i = 0; i < 4; ++i) { int c = tid + i * 512; *(uint4*)(sW + (c >> 4) * 136 + (c & 15) * 8) = wv4[i]; }
  }
  __syncthreads();
  {
    const int rl = tid >> 3, cg8 = tid & 7;
    const int lrow = isP ? 15 + rl : (rl >> 3) * 23 + 15 + (rl & 7);
    float sum[16], cur[16];
#pragma unroll
    for (int j = 0; j < 16; ++j) { sum[j] = 0.f; cur[j] = 0.f; }
    float cnt = (float)wnd;
    if (isP) cnt = (float)min(wnd, t0 + rl + 1);
    for (int i = 0; i < wnd; ++i) {
      float f[16];
      const bfraw* s = U + (lrow - i) * 136 + cg8 * 16;
      unpack8(*(const uint4*)s, f); unpack8(*(const uint4*)(s + 8), f + 8);
#pragma unroll
      for (int j = 0; j < 16; ++j) sum[j] += f[j];
      if (i == 0) {
#pragma unroll
        for (int j = 0; j < 16; ++j) cur[j] = f[j];
      }
    }
    float d[16];
    const float ic = 1.f / cnt;
#pragma unroll
    for (int j = 0; j < 16; ++j) d[j] = (rl < nrows) ? (sum[j] * ic - cur[j]) : 0.f;
    *(uint4*)(dA + rl * 136 + cg8 * 16) = pack8(d);
    *(uint4*)(dA + rl * 136 + cg8 * 16 + 8) = pack8(d + 8);
  }
  __syncthreads();
  f32x4 acc[4];
#pragma unroll
  for (int i = 0; i < 4; ++i) acc[i] = (f32x4){0.f, 0.f, 0.f, 0.f};
#pragma unroll
  for (int kk = 0; kk < 4; ++kk) {
    bf16x8 bfr = *(const bf16x8*)(sW + (w * 16 + r) * 136 + kk * 32 + q * 8);
#pragma unroll
    for (int mt = 0; mt < 4; ++mt) {
      bf16x8 af = *(const bf16x8*)(dA + (mt * 16 + r) * 136 + kk * 32 + q * 8);
      acc[mt] = mfma16(af, bfr, acc[mt]);
    }
  }
  const float sc = p.pool_scale[l * 512 + g * 128 + w * 16 + r];
#pragma unroll
  for (int mt = 0; mt < 4; ++mt)
#pragma unroll
    for (int gg = 0; gg < 4; ++gg) {
      int rl = mt * 16 + q * 4 + gg;
      if (rl < nrows) OA[(size_t)(grow0 + rl) * 512 + g * 128 + w * 16 + r] = f2bf(acc[mt][gg] * sc);
    }
  __syncthreads();
}

constexpr int L_W = 0;
constexpr int L_QG = 17408;
constexpr int L_KGT = 34816;
constexpr int L_QK = 53248;
constexpr int L_UT = 62464;
constexpr int L_ST = 80896;
constexpr int L_DLT = 115712;
constexpr int L_PART = 134144;
constexpr int L_RHS = 80896;
constexpr int L_MM = 80896 + 65536;
constexpr int L_MISC = 162816;
constexpr int LDS_BYTES = 163840;

__device__ __forceinline__ int dchunk_lds(int c) {
  if (c < 2048) { int a = c >> 10, cl = c & 1023; return (a ? L_QG : L_W) + (cl >> 4) * 272 + (cl & 15) * 16; }
  if (c < 3072) { int cl = c - 2048; return L_KGT + (cl >> 3) * 144 + (cl & 7) * 16; }
  if (c < 3584) { int cl = c - 3072; return L_QK + (cl >> 3) * 144 + (cl & 7) * 16; }
  int cl = c - 3584; return L_UT + (cl >> 3) * 144 + (cl & 7) * 16;
}

__device__ __forceinline__ float delta_prep(const Params& p, int l, int h, bool isP, int grow0, int t0, int nvalid, int bb, char* sm) {
  const int tid = opq(threadIdx.x), lane = tid & 63, w = tid >> 6, r = lane & 15, q = lane >> 4;
  const bfraw* B1 = (const bfraw*)(p.ws + WS_B1);
  const float* BA = (const float*)(p.ws + WS_BA);
  bfraw* raw = (bfraw*)(sm + L_RHS);
  float* misc = (float*)(sm + L_MISC);
  {
    uint4 sv[7];
#pragma unroll
    for (int i = 0; i < 7; ++i) {
      const int c = tid + i * NTHR;
      uint4 v = make_uint4(0u, 0u, 0u, 0u);
      if (c < 3 * 67 * 16) {
        int arr = c / 1072, rem = c - arr * 1072, rr = rem >> 4, ch = rem & 15;
        int tl = rr - 3;
        const int col = 512 + arr * 512 + h * 128 + ch * 8;
        if (isP) {
          if (t0 + tl >= 0 && tl < nvalid) v = *(const uint4*)(B1 + (size_t)(grow0 + tl) * LD1 + col);
        } else {
          if (tl >= 0) { if (tl < nvalid) v = *(const uint4*)(B1 + (size_t)(grow0 + tl) * LD1 + col); }
          else {
            const float* s = p.state_conv + ((size_t)(l * NBS + bb) * 3 + rr) * 1536 + arr * 512 + h * 128 + ch * 8;
            float4 f0 = *(const float4*)s, f1 = *(const float4*)(s + 4);
            v.x = pack2(f0.x, f0.y); v.y = pack2(f0.z, f0.w); v.z = pack2(f1.x, f1.y); v.w = pack2(f1.z, f1.w);
          }
        }
      }
      sv[i] = v;
    }
#pragma unroll
    for (int i = 0; i < 7; ++i) {
      const int c = tid + i * NTHR;
      if (c < 3 * 67 * 16) {
        int arr = c / 1072, rem = c - arr * 1072, rr = rem >> 4, ch = rem & 15;
        *(uint4*)(raw + (arr * 67 + rr) * 136 + ch * 8) = sv[i];
      }
    }
  }
  if (w == 0) {
    float bt = 0.f, g = 0.f;
    if (lane < nvalid) {
      const float* ba = BA + (size_t)(grow0 + lane) * 8;
      bt = sigmoidf_(ba[h]);
      float xa = ba[4 + h] + p.dt_bias[l * 4 + h];
      float sp = fmaxf(xa, 0.f) + log1pf(expf(-fabsf(xa)));
      g = -expf(p.a_log[l * 4 + h]) * sp;
    }
    float G = g;
#pragma unroll
    for (int o = 1; o < 64; o <<= 1) { float t = __shfl_up(G, o); if (lane >= o) G += t; }
    misc[lane] = G; misc[64 + lane] = bt; misc[128 + lane] = expf(G);
  }
  __syncthreads();
  const int rl = tid >> 3, cg8 = tid & 7;
  float qf[16], kf[16], vf[16];
  {
    const float* cw = p.conv_w + (size_t)l * 4 * 1536 + h * 128 + cg8 * 16;
#pragma unroll
    for (int arr = 0; arr < 3; ++arr) {
      float y[16];
#pragma unroll
      for (int j = 0; j < 16; ++j) y[j] = 0.f;
      if (rl < nvalid) {
#pragma unroll
      for (int j = 0; j < 4; ++j) {
        float f[16], wv[16];
        const bfraw* s = raw + (arr * 67 + rl + j) * 136 + cg8 * 16;
        unpack8(*(const uint4*)s, f); unpack8(*(const uint4*)(s + 8), f + 8);
#pragma unroll
        for (int e = 0; e < 4; ++e) {
          float4 t4 = *(const float4*)(cw + j * 1536 + arr * 512 + e * 4);
          wv[e * 4] = t4.x; wv[e * 4 + 1] = t4.y; wv[e * 4 + 2] = t4.z; wv[e * 4 + 3] = t4.w;
        }
#pragma unroll
        for (int e = 0; e < 16; ++e) y[e] += f[e] * wv[e];
      }
      float ss = 0.f;
#pragma unroll
      for (int e = 0; e < 16; ++e) { float v = y[e]; v = v * sigmoidf_(v); y[e] = v; ss += v * v; }
      if (arr < 2) {
        ss += __shfl_xor(ss, 1); ss += __shfl_xor(ss, 2); ss += __shfl_xor(ss, 4);
        float sc = rsqrtf(ss + EPS) * (arr == 0 ? 0.08838834764831845f : 1.f);
#pragma unroll
        for (int e = 0; e < 16; ++e) y[e] *= sc;
      }
      }
      const bool ok = rl < nvalid;
#pragma unroll
      for (int e = 0; e < 16; ++e) {
        float v = ok ? y[e] : 0.f;
        if (arr == 0) qf[e] = v; else if (arr == 1) kf[e] = v; else vf[e] = v;
      }
    }
    bfraw* qh = (bfraw*)(sm + L_QG);
    bfraw* kh = (bfraw*)(sm + L_W);
    *(uint4*)(qh + rl * 136 + cg8 * 16) = pack8(qf); *(uint4*)(qh + rl * 136 + cg8 * 16 + 8) = pack8(qf + 8);
    *(uint4*)(kh + rl * 136 + cg8 * 16) = pack8(kf); *(uint4*)(kh + rl * 136 + cg8 * 16 + 8) = pack8(kf + 8);
  }
  __syncthreads();
  {
    float* rhs = (float*)(sm + L_RHS);
    const float bt = misc[64 + rl], eg = misc[128 + rl];
#pragma unroll
    for (int e = 0; e < 16; ++e) {
      rhs[rl * 256 + cg8 * 16 + e] = vf[e] * bt;
      rhs[rl * 256 + 128 + cg8 * 16 + e] = kf[e] * bt * eg;
    }
  }
  {
    const bfraw* kh = (const bfraw*)(sm + L_W);
    const bfraw* ah = (w < 4) ? kh : (const bfraw*)(sm + L_QG);
    const int mt = w & 3;
    f32x4 acc[4];
#pragma unroll
    for (int i = 0; i < 4; ++i) acc[i] = (f32x4){0.f, 0.f, 0.f, 0.f};
#pragma unroll
    for (int kk = 0; kk < 4; ++kk) {
      bf16x8 af = *(const bf16x8*)(ah + (mt * 16 + r) * 136 + kk * 32 + q * 8);
#pragma unroll
      for (int nt = 0; nt < 4; ++nt) {
        bf16x8 bfr = *(const bf16x8*)(kh + (nt * 16 + r) * 136 + kk * 32 + q * 8);
        acc[nt] = mfma16(af, bfr, acc[nt]);
      }
    }
    float* Mm = (float*)(sm + L_MM);
    bfraw* qk = (bfraw*)(sm + L_QK);
#pragma unroll
    for (int nt = 0; nt < 4; ++nt)
#pragma unroll
      for (int g = 0; g < 4; ++g) {
        const int i = mt * 16 + q * 4 + g, j = nt * 16 + r;
        const float Gi = misc[i], Gj = misc[j];
        if (w < 4) {
          float v = (j < i) ? acc[nt][g] * __expf(Gi - Gj) * misc[64 + i] : 0.f;
          Mm[j * 64 + i] = v;
          ((bfraw*)(sm + L_KGT))[i * 72 + j] = f2bf(v);
        } else {
          float v = (j <= i) ? acc[nt][g] * __expf(Gi - Gj) : 0.f;
          qk[i * 72 + j] = f2bf(v);
        }
      }
  }
  __syncthreads();
  bfraw* XTu = (bfraw*)(sm + L_UT);
  bfraw* XTw = (bfraw*)(sm + L_W);
  {
    const uint4 z4 = make_uint4(0u, 0u, 0u, 0u);
    for (int c = tid; c < 128 * 9; c += NTHR) { *(uint4*)(XTu + c * 8) = z4; *(uint4*)(XTw + c * 8) = z4; }
  }
  __syncthreads();
  {
    float* xs = (float*)(sm + L_RHS);
    const float* MT = (const float*)(sm + L_MM);
    const bfraw* Mb = (const bfraw*)(sm + L_KGT);
#pragma unroll
    for (int ib = 0; ib < 4; ++ib) {
      if (ib * 16 >= nvalid) break;
      if (ib > 0) {
        f32x4 a0 = (f32x4){0.f, 0.f, 0.f, 0.f}, a1 = a0;
        const bfraw* xb0 = (w < 4) ? XTu + ((2 * w) * 16 + r) * 72 : XTw + ((2 * w - 8) * 16 + r) * 72;
        const bfraw* xb1 = xb0 + 16 * 72;
#pragma unroll
        for (int kk = 0; kk < 2; ++kk) {
          if (kk * 32 < ib * 16) {
            bf16x8 am = *(const bf16x8*)(Mb + (ib * 16 + r) * 72 + kk * 32 + q * 8);
            bf16x8 b0 = *(const bf16x8*)(xb0 + kk * 32 + q * 8);
            bf16x8 b1 = *(const bf16x8*)(xb1 + kk * 32 + q * 8);
            a0 = mfma16(am, b0, a0);
            a1 = mfma16(am, b1, a1);
          }
        }
#pragma unroll
        for (int g = 0; g < 4; ++g) {
          float* rp = xs + (ib * 16 + q * 4 + g) * 256 + w * 32 + r;
          rp[0] -= a0[g];
          rp[16] -= a1[g];
        }
        __syncthreads();
      }
      if (tid < 256) {
        float a[16];
#pragma unroll
        for (int ii = 0; ii < 16; ++ii) a[ii] = xs[(ib * 16 + ii) * 256 + tid];
#pragma unroll
        for (int j = 0; j < 16; ++j) {
          const float xj = a[j];
          const float* mp = MT + (ib * 16 + j) * 64 + ib * 16;
#pragma unroll
          for (int ii = j + 1; ii < 16; ++ii) a[ii] -= mp[ii] * xj;
        }
        bfraw* dst = (tid < 128) ? XTu + tid * 72 + ib * 16 : XTw + (tid - 128) * 72 + ib * 16;
        *(uint4*)dst = pack8(a);
        *(uint4*)(dst + 8) = pack8(a + 8);
      }
      __syncthreads();
    }
  }
  uint4 wreg[8];
  if (tid >= 128 && tid < 256) {
#pragma unroll
    for (int c = 0; c < 8; ++c) wreg[c] = *(const uint4*)(XTw + (tid - 128) * 72 + c * 8);
  }
  __syncthreads();
  if (tid >= 128 && tid < 256) {
    bfraw* wl = (bfraw*)(sm + L_W);
#pragma unroll
    for (int c = 0; c < 8; ++c) {
      const unsigned u4[4] = {wreg[c].x, wreg[c].y, wreg[c].z, wreg[c].w};
#pragma unroll
      for (int e = 0; e < 4; ++e) {
        wl[(c * 8 + e * 2) * 136 + (tid - 128)] = (bfraw)(u4[e] & 0xffffu);
        wl[(c * 8 + e * 2 + 1) * 136 + (tid - 128)] = (bfraw)(u4[e] >> 16);
      }
    }
  }
  const float Glast = misc[63];
  {
    const float eg = misc[128 + rl];
    const float ek = __expf(Glast - misc[rl]);
    bfraw* qg = (bfraw*)(sm + L_QG);
    bfraw* kgT = (bfraw*)(sm + L_KGT);
    float t[16];
#pragma unroll
    for (int e = 0; e < 16; ++e) t[e] = qf[e] * eg;
    *(uint4*)(qg + rl * 136 + cg8 * 16) = pack8(t); *(uint4*)(qg + rl * 136 + cg8 * 16 + 8) = pack8(t + 8);
#pragma unroll
    for (int e = 0; e < 16; ++e) kgT[(cg8 * 16 + e) * 72 + rl] = f2bf(kf[e] * ek);
  }
  const float gl = expf(Glast);
  __syncthreads();
  return gl;
}

constexpr int L_KGT2 = 124928;
constexpr int L_QK2 = 143360;
__device__ __forceinline__ void write_St2(const f32x4 (&S)[2], char* sm) {
  const int tid_ = opq(threadIdx.x);
  const int lane = tid_ & 63, w = tid_ >> 6, r = lane & 15, q = lane >> 4;
  bfraw* St = (bfraw*)(sm + L_ST);
#pragma unroll
  for (int nd = 0; nd < 2; ++nd) {
    uint2 v; v.x = pack2(S[nd][0], S[nd][1]); v.y = pack2(S[nd][2], S[nd][3]);
    *(uint2*)(St + (nd * 16 + r) * 136 + w * 16 + q * 4) = v;
  }
}
__device__ __forceinline__ void step_part1(char* sm, int off_ut, f32x4& o) {
  const int tid_ = opq(threadIdx.x);
  const int lane = tid_ & 63, w = tid_ >> 6, r = lane & 15, q = lane >> 4;
  const int mj = w >> 1, nd = w & 1;
  const bfraw* wl = (const bfraw*)(sm + L_W);
  const bfraw* qg = (const bfraw*)(sm + L_QG);
  const bfraw* uT = (const bfraw*)(sm + off_ut);
  const bfraw* St = (const bfraw*)(sm + L_ST);
  bfraw* dltT = (bfraw*)(sm + L_DLT);
  f32x4 dl = (f32x4){0.f, 0.f, 0.f, 0.f};
  o = (f32x4){0.f, 0.f, 0.f, 0.f};
#pragma unroll
  for (int kk = 0; kk < 4; ++kk) {
    bf16x8 sb = *(const bf16x8*)(St + (nd * 16 + r) * 136 + kk * 32 + q * 8);
    bf16x8 aw = *(const bf16x8*)(wl + (mj * 16 + r) * 136 + kk * 32 + q * 8);
    bf16x8 aq = *(const bf16x8*)(qg + (mj * 16 + r) * 136 + kk * 32 + q * 8);
    dl = mfma16(aw, sb, dl);
    o = mfma16(aq, sb, o);
  }
  uint2 uv = *(const uint2*)(uT + (nd * 16 + r) * 72 + mj * 16 + q * 4);
  uint2 dv;
  dv.x = pack2(lo2f(uv.x) - dl[0], hi2f(uv.x) - dl[1]);
  dv.y = pack2(lo2f(uv.y) - dl[2], hi2f(uv.y) - dl[3]);
  *(uint2*)(dltT + (nd * 16 + r) * 72 + mj * 16 + q * 4) = dv;
}
__device__ __forceinline__ void step_part2(const Params& p, char* sm, int off_kgt, int off_qk, int h, int s, int grow0, int nvalid,
                                           float gl, f32x4& o, f32x4 (&S)[2]) {
  const int tid_ = opq(threadIdx.x);
  const int lane = tid_ & 63, w = tid_ >> 6, r = lane & 15, q = lane >> 4;
  const int mj = w >> 1, nd = w & 1;
  const bfraw* kgT = (const bfraw*)(sm + off_kgt);
  const bfraw* qk = (const bfraw*)(sm + off_qk);
  const bfraw* dltT = (const bfraw*)(sm + L_DLT);
#pragma unroll
  for (int g = 0; g < 4; ++g) { S[0][g] *= gl; S[1][g] *= gl; }
#pragma unroll
  for (int kk = 0; kk < 2; ++kk) {
    bf16x8 d0 = *(const bf16x8*)(dltT + (r) * 72 + kk * 32 + q * 8);
    bf16x8 d1 = *(const bf16x8*)(dltT + (16 + r) * 72 + kk * 32 + q * 8);
    bf16x8 aqk = *(const bf16x8*)(qk + (mj * 16 + r) * 72 + kk * 32 + q * 8);
    bf16x8 ak = *(const bf16x8*)(kgT + (w * 16 + r) * 72 + kk * 32 + q * 8);
    o = mfma16(aqk, nd ? d1 : d0, o);
    S[0] = mfma16(ak, d0, S[0]);
    S[1] = mfma16(ak, d1, S[1]);
  }
  write_St2(S, sm);
  bfraw* OB = (bfraw*)(p.ws + WS_B1);
#pragma unroll
  for (int g = 0; g < 4; ++g) {
    const int j = mj * 16 + q * 4 + g;
    if (j < nvalid) OB[(size_t)(grow0 + j) * LD1 + h * 128 + s * 32 + nd * 16 + r] = f2bf(o[g]);
  }
}
__device__ __forceinline__ int s2_lane_off(int s) {
  const int tid_ = opq(threadIdx.x);
  const int lane = tid_ & 63, w = tid_ >> 6, r = lane & 15, q = lane >> 4;
  int off = (w * 16 + q * 4) * 128 + s * 32 + r;
  asm volatile("" : "+v"(off));
  return off;
}
__device__ __forceinline__ void store_S2(const f32x4 (&S)[2], float* dst, int s) {
  float* b = dst + s2_lane_off(s);
#pragma unroll
  for (int nd = 0; nd < 2; ++nd)
#pragma unroll
    for (int g = 0; g < 4; ++g) b[g * 128 + nd * 16] = S[nd][g];
}
__device__ __forceinline__ void load_S2(f32x4 (&S)[2], const float* src, int s) {
  const float* b = src + s2_lane_off(s);
#pragma unroll
  for (int nd = 0; nd < 2; ++nd)
#pragma unroll
    for (int g = 0; g < 4; ++g) S[nd][g] = b[g * 128 + nd * 16];
}

__device__ __forceinline__ void f1_unit(const Params& p, int l, int u, char* sm) {
  const int b = u / (NCH * 4), rem = u - b * NCH * 4, c = rem >> 2, h = rem & 3;
  int t0, nvalid;
  if (c == 0) { t0 = 0; nvalid = 16; } else { t0 = 16 + (c - 1) * 64; nvalid = 64; }
  float gl = delta_prep(p, l, h, true, b * TP + t0, t0, nvalid, 0, sm);
  bfraw* D = (bfraw*)(p.ws + WS_D) + (size_t)u * DUNIT;
  for (int cidx = opq(threadIdx.x); cidx < 4608; cidx += NTHR)
    *(uint4*)(D + (size_t)cidx * 8) = *(const uint4*)(sm + dchunk_lds(cidx));
  if (opq(threadIdx.x) == 0) ((float*)(p.ws + WS_GL))[u] = gl;
  __syncthreads();
}

__device__ __forceinline__ void sample_delta_unit(const Params& p, int l, int su, char* sm) {
  const int bb = su >> 2, h = su & 3;
  const int grow0 = ROWS_P + bb * TS;
  float gl = delta_prep(p, l, h, false, grow0, 0, TS, bb, sm);
  const float* S0 = p.state_delta + ((size_t)(l * NBS + bb) * 4 + h) * 128 * 128;
  float* S1 = p.out + O_DELTAS + ((size_t)(l * NBS + bb) * 4 + h) * 128 * 128;
#pragma unroll 1
  for (int s = 0; s < 4; ++s) {
    f32x4 S[2], o;
    load_S2(S, S0, s);
    write_St2(S, sm);
    __syncthreads();
    step_part1(sm, L_UT + s * 32 * 144, o);
    __syncthreads();
    step_part2(p, sm, L_KGT, L_QK, h, s, grow0, TS, gl, o, S);
    store_S2(S, S1, s);
  }
  __syncthreads();
}

__device__ __forceinline__ void scan_unit(const Params& p, int l, int bhs, char* sm) {
  const int s = (bhs >> 3) & 3, bh = (bhs & 7) * 2 + (bhs >> 5), b = bh >> 2, h = bh & 3;
  const int tid = opq(threadIdx.x);
  f32x4 S[2];
  S[0] = (f32x4){0.f, 0.f, 0.f, 0.f}; S[1] = (f32x4){0.f, 0.f, 0.f, 0.f};
  write_St2(S, sm);
  const float* GL = (const float*)(p.ws + WS_GL);
  uint4 a0, a1, a2, a3, a4, a5, a6, a7, b0, b1, b2, b3, b4, b5, b6, b7;
  float gla, glb;
#define PRE_LOAD(P, GLV, C) { const int cc_ = ((C) < NCH) ? (C) : NCH - 1; const int U_ = (b * NCH + cc_) * 4 + h; \
    const bfraw* D_ = (const bfraw*)(p.ws + WS_D) + (size_t)U_ * DUNIT + (size_t)tid * 8; \
    P##0 = *(const uint4*)(D_); P##1 = *(const uint4*)(D_ + 4096); P##2 = *(const uint4*)(D_ + 2 * 4096); P##3 = *(const uint4*)(D_ + 3 * 4096); \
    P##4 = *(const uint4*)(D_ + 4 * 4096); P##5 = *(const uint4*)(D_ + 5 * 4096); P##6 = *(const uint4*)(D_ + 6 * 4096); \
    P##7 = *(const uint4*)(D_ + 7 * 4096 + s * 2048 - ((tid >= 256) ? 2048 : 0)); GLV = GL[U_]; }
#define LDS_PUT(P, KB) { \
    *(uint4*)(sm + L_W + (tid >> 4) * 272 + (tid & 15) * 16) = P##0; \
    *(uint4*)(sm + L_W + (32 + (tid >> 4)) * 272 + (tid & 15) * 16) = P##1; \
    *(uint4*)(sm + L_QG + (tid >> 4) * 272 + (tid & 15) * 16) = P##2; \
    *(uint4*)(sm + L_QG + (32 + (tid >> 4)) * 272 + (tid & 15) * 16) = P##3; \
    *(uint4*)(sm + ((KB) ? L_KGT2 : L_KGT) + (tid >> 3) * 144 + (tid & 7) * 16) = P##4; \
    *(uint4*)(sm + ((KB) ? L_KGT2 : L_KGT) + (64 + (tid >> 3)) * 144 + (tid & 7) * 16) = P##5; \
    *(uint4*)(sm + ((KB) ? L_QK2 : L_QK) + (tid >> 3) * 144 + (tid & 7) * 16) = P##6; \
    if (tid < 256) *(uint4*)(sm + L_UT + (tid >> 3) * 144 + (tid & 7) * 16) = P##7; }
#define SCAN_STEP(C, KB, GLV) { \
    __syncthreads(); \
    int t0_, nv_; \
    if ((C) == 0) { t0_ = 0; nv_ = 16; } else { t0_ = 16 + ((C) - 1) * 64; nv_ = 64; } \
    f32x4 o_; \
    step_part1(sm, L_UT, o_); \
    __syncthreads(); \
    step_part2(p, sm, (KB) ? L_KGT2 : L_KGT, (KB) ? L_QK2 : L_QK, h, s, b * TP + t0_, nv_, GLV, o_, S); }
  PRE_LOAD(a, gla, 0)
  PRE_LOAD(b, glb, 1)
  for (int c = 0; c < NCH; c += 2) {
    LDS_PUT(a, 0)
    const float gl0 = gla;
    PRE_LOAD(a, gla, c + 2)
    SCAN_STEP(c, 0, gl0)
    if (c + 1 < NCH) {
      LDS_PUT(b, 1)
      const float gl1 = glb;
      PRE_LOAD(b, glb, c + 3)
      SCAN_STEP(c + 1, 1, gl1)
    }
  }
  store_S2(S, p.out + O_DELTAP + ((size_t)(l * NBP + b) * 4 + h) * 128 * 128, s);
#undef PRE_LOAD
#undef LDS_PUT
#undef SCAN_STEP
}

__device__ __forceinline__ void ob_finalize(const Params& p, int l) {
  const int tid = opq(threadIdx.x), lane = tid & 63, w = tid >> 6;
  bfraw* OB = (bfraw*)(p.ws + WS_B1);
  const bfraw* B2 = (const bfraw*)(p.ws + WS_B2);
  float ow[8];
#pragma unroll
  for (int e = 0; e < 8; ++e) ow[e] = p.onorm_w[l * 128 + (lane & 15) * 8 + e];
  for (int r0 = blockIdx.x * 8 + w; r0 < ROWS; r0 += gridDim.x * 8 * 2) {
    uint4 ov[2], zv[2];
#pragma unroll
    for (int k = 0; k < 2; ++k) {
      const int row = r0 + k * gridDim.x * 8;
      if (row < ROWS) {
        ov[k] = *(const uint4*)(OB + (size_t)row * LD1 + lane * 8);
        zv[k] = *(const uint4*)(B2 + (size_t)row * LD2 + lane * 8);
      } else { ov[k] = make_uint4(0u, 0u, 0u, 0u); zv[k] = ov[k]; }
    }
#pragma unroll
    for (int k = 0; k < 2; ++k) {
      const int row = r0 + k * gridDim.x * 8;
      float o[8], z[8];
      unpack8(ov[k], o); unpack8(zv[k], z);
      float ss = 0.f;
#pragma unroll
      for (int e = 0; e < 8; ++e) ss += o[e] * o[e];
      ss += __shfl_xor(ss, 1); ss += __shfl_xor(ss, 2); ss += __shfl_xor(ss, 4); ss += __shfl_xor(ss, 8);
      const float rinv = rsqrtf(ss * (1.f / 128.f) + EPS);
#pragma unroll
      for (int e = 0; e < 8; ++e) o[e] = o[e] * rinv * ow[e] * (z[e] * sigmoidf_(z[e]));
      if (row < ROWS) *(uint4*)(OB + (size_t)row * LD1 + lane * 8) = pack8(o);
    }
  }
}

__device__ __forceinline__ void swa_item(const Params& p, int l, int it, char* sm) {
  const int tid = opq(threadIdx.x), lane = tid & 63, w = tid >> 6, r = lane & 15, q = lane >> 4;
  bfraw* Qs = (bfraw*)sm;
  bfraw* Ks = (bfraw*)(sm + 36864);
  bfraw* VT = (bfraw*)(sm + 36864 + 27648);
  bfraw* B2 = (bfraw*)(p.ws + WS_B2);
  const int NPI = NBP * 2 * NCH;
  bool isP = it < NPI;
  int kvh, qrow0, nq, bb = 0, q0 = 0, rowb;
  if (isP) {
    int b = it / (2 * NCH), rem = it - b * 2 * NCH; kvh = rem / NCH; int qt = rem - kvh * NCH;
    q0 = qt * 64; nq = min(64, TP - q0); rowb = b * TP; qrow0 = rowb + q0;
  } else {
    int s = it - NPI; bb = s >> 1; kvh = s & 1; nq = TS; rowb = ROWS_P + bb * TS; qrow0 = rowb;
  }
#pragma unroll
  for (int i = 0; i < 4; ++i) {
    int c = tid + i * 512; int rr = c >> 3, ch = c & 7; int g = rr >> 6, t = rr & 63;
    uint4 v = make_uint4(0u, 0u, 0u, 0u);
    if (t < nq) v = *(const uint4*)(B2 + (size_t)(qrow0 + t) * LD2 + 512 + (kvh * 4 + g) * 64 + ch * 8);
    *(uint4*)(Qs + rr * 72 + ch * 8) = v;
  }
#pragma unroll
  for (int i = 0; i < 3; ++i) {
    int c = tid + i * 512; int j = c >> 3, ch = c & 7;
    uint4 v = make_uint4(0u, 0u, 0u, 0u);
    if (isP) {
      int pos = q0 - 128 + j;
      if (pos >= 0 && pos < TP) v = *(const uint4*)(B2 + (size_t)(rowb + pos) * LD2 + 1024 + kvh * 64 + ch * 8);
    } else {
      if (j < 128) {
        const float* s = p.cache_k + (((size_t)(l * NBS + bb) * 128 + j) * 2 + kvh) * 64 + ch * 8;
        float f[8];
#pragma unroll
        for (int e = 0; e < 8; ++e) f[e] = s[e];
        v = pack8(f);
      } else if (j < 128 + TS) v = *(const uint4*)(B2 + (size_t)(rowb + j - 128) * LD2 + 1024 + kvh * 64 + ch * 8);
    }
    *(uint4*)(Ks + j * 72 + ch * 8) = v;
  }
#pragma unroll
  for (int ci = 0; ci < 3; ++ci) {
    const int c = tid + ci * NTHR;
    int ch = c / 192, j = c - ch * 192;
    float f[8];
#pragma unroll
    for (int e = 0; e < 8; ++e) f[e] = 0.f;
    if (isP) {
      int pos = q0 - 128 + j;
      if (pos >= 0 && pos < TP) unpack8(*(const uint4*)(B2 + (size_t)(rowb + pos) * LD2 + 1152 + kvh * 64 + ch * 8), f);
    } else {
      if (j < 128) {
        const float* s = p.cache_v + (((size_t)(l * NBS + bb) * 128 + j) * 2 + kvh) * 64 + ch * 8;
#pragma unroll
        for (int e = 0; e < 8; ++e) f[e] = s[e];
      } else if (j < 128 + TS) unpack8(*(const uint4*)(B2 + (size_t)(rowb + j - 128) * LD2 + 1152 + kvh * 64 + ch * 8), f);
    }
#pragma unroll
    for (int e = 0; e < 8; ++e) VT[(ch * 8 + e) * 200 + j] = f2bf(f[e]);
  }
  __syncthreads();
  const int g = w >> 1, qh = w & 1;
  const float sink = p.sinks[l * 8 + kvh * 4 + g];
  const int jmin = isP ? max(0, 128 - q0) : 0;
#pragma unroll 1
  for (int nt = 0; nt < 2; ++nt) {
    const int tq0 = qh * 32 + nt * 16;
    if (tq0 >= nq) break;
    bf16x8 qf[2];
#pragma unroll
    for (int kk = 0; kk < 2; ++kk) qf[kk] = *(const bf16x8*)(Qs + (g * 64 + tq0 + r) * 72 + kk * 32 + q * 8);
    const int mt0 = tq0 >> 4;
    f32x4 s[9];
#pragma unroll
    for (int i = 0; i < 9; ++i) {
      s[i] = (f32x4){0.f, 0.f, 0.f, 0.f};
#pragma unroll
      for (int kk = 0; kk < 2; ++kk) {
        bf16x8 kf = *(const bf16x8*)(Ks + ((mt0 + i) * 16 + r) * 72 + kk * 32 + q * 8);
        s[i] = mfma16(kf, qf[kk], s[i]);
      }
    }
    const int t = tq0 + r;
    float mx = sink;
#pragma unroll
    for (int i = 0; i < 9; ++i)
#pragma unroll
      for (int gg = 0; gg < 4; ++gg) {
        const int j = (mt0 + i) * 16 + q * 4 + gg;
        const bool ok = (j >= t + 1) && (j <= 128 + t) && (j >= jmin) && (t < nq);
        float v = ok ? s[i][gg] : -INFINITY;
        s[i][gg] = v;
        mx = fmaxf(mx, v);
      }
    mx = fmaxf(mx, __shfl_xor(mx, 16)); mx = fmaxf(mx, __shfl_xor(mx, 32));
    float sum = 0.f;
#pragma unroll
    for (int i = 0; i < 9; ++i)
#pragma unroll
      for (int gg = 0; gg < 4; ++gg) {
        float e = __expf(s[i][gg] - mx);
        s[i][gg] = e;
        sum += e;
      }
    sum += __shfl_xor(sum, 16); sum += __shfl_xor(sum, 32);
    const float inv = 1.f / (sum + __expf(sink - mx));
    f32x4 o[4];
#pragma unroll
    for (int dm = 0; dm < 4; ++dm) o[dm] = (f32x4){0.f, 0.f, 0.f, 0.f};
#pragma unroll
    for (int ks = 0; ks < 5; ++ks) {
      union { bf16x8 v; unsigned u[4]; } cv;
      cv.u[0] = pack2(s[2 * ks][0], s[2 * ks][1]);
      cv.u[1] = pack2(s[2 * ks][2], s[2 * ks][3]);
      if (ks < 4) { cv.u[2] = pack2(s[2 * ks + 1][0], s[2 * ks + 1][1]); cv.u[3] = pack2(s[2 * ks + 1][2], s[2 * ks + 1][3]); }
      else { cv.u[2] = 0u; cv.u[3] = 0u; }
      const int kb = (mt0 + 2 * ks) * 16;
#pragma unroll
      for (int dm = 0; dm < 4; ++dm) {
        union { bf16x8 v; uint2 u[2]; } av;
        av.u[0] = *(const uint2*)(VT + (dm * 16 + r) * 200 + kb + q * 4);
        if (ks < 4) av.u[1] = *(const uint2*)(VT + (dm * 16 + r) * 200 + kb + 16 + q * 4);
        else av.u[1] = make_uint2(0u, 0u);
        o[dm] = mfma16(av.v, cv.v, o[dm]);
      }
    }
    if (t < nq) {
#pragma unroll
      for (int dm = 0; dm < 4; ++dm) {
        uint2 v;
        v.x = pack2(o[dm][0] * inv, o[dm][1] * inv);
        v.y = pack2(o[dm][2] * inv, o[dm][3] * inv);
        *(uint2*)(B2 + (size_t)(qrow0 + t) * LD2 + 512 + (kvh * 4 + g) * 64 + dm * 16 + q * 4) = v;
      }
    }
  }
  __syncthreads();
}

__device__ __forceinline__ float4 ld4bf(const bfraw* s) { uint2 v = *(const uint2*)s; return make_float4(lo2f(v.x), hi2f(v.x), lo2f(v.y), hi2f(v.y)); }
__device__ __forceinline__ void state_copies(const Params& p, int l, int bid, int nb) {
  const bfraw* B1 = (const bfraw*)(p.ws + WS_B1);
  const bfraw* B2 = (const bfraw*)(p.ws + WS_B2);
  constexpr int N0 = 4 * 15 * 512, N1 = 4 * 3 * 1536, N2 = 128 * 15 * 512, N3 = 128 * 3 * 1536, N4 = 4 * 128 * 128, N5 = 128 * 128 * 128;
  constexpr int TOT = N0 + N1 + N2 + N3 + 2 * N4 + 2 * N5;
#pragma unroll 4
  for (int i = (bid * NTHR + opq(threadIdx.x)) * 4; i < TOT; i += nb * NTHR * 4) {
    int e = i;
    float4 v; float* dst;
    if (e < N0) { int b = e / (15 * 512), rem = e % (15 * 512), j = rem >> 9, c = rem & 511;
      v = ld4bf(B1 + (size_t)(b * TP + 8193 + j) * LD1 + c); dst = p.out + O_POOLP + (size_t)l * N0 + e; }
    else if ((e -= N0) < N1) { int b = e / (3 * 1536), rem = e % (3 * 1536), j = rem / 1536, c = rem % 1536;
      v = ld4bf(B1 + (size_t)(b * TP + 8205 + j) * LD1 + 512 + c); dst = p.out + O_CONVP + (size_t)l * N1 + e; }
    else if ((e -= N1) < N2) { int b = e / (15 * 512), rem = e % (15 * 512), j = rem >> 9, c = rem & 511;
      if (j < 7) v = *(const float4*)(p.state_pool + ((size_t)(l * NBS + b) * 15 + j + 8) * 512 + c);
      else v = ld4bf(B1 + (size_t)(ROWS_P + b * TS + j - 7) * LD1 + c);
      dst = p.out + O_POOLS + (size_t)l * N2 + e; }
    else if ((e -= N2) < N3) { int b = e / (3 * 1536), rem = e % (3 * 1536), j = rem / 1536, c = rem % 1536;
      v = ld4bf(B1 + (size_t)(ROWS_P + b * TS + 5 + j) * LD1 + 512 + c); dst = p.out + O_CONVS + (size_t)l * N3 + e; }
    else if ((e -= N3) < 2 * N4) { int kv = e / N4, e2 = e % N4; int b = e2 >> 14, j = (e2 >> 7) & 127, c = e2 & 127;
      v = ld4bf(B2 + (size_t)(b * TP + 8080 + j) * LD2 + 1024 + kv * 128 + c); dst = p.out + (kv ? O_VP : O_KP) + (size_t)l * N4 + e2; }
    else { e -= 2 * N4; int kv = e / N5, e2 = e % N5; int b = e2 >> 14, j = (e2 >> 7) & 127, c = e2 & 127;
      const float* cache = kv ? p.cache_v : p.cache_k;
      if (j < 120) v = *(const float4*)(cache + ((size_t)(l * NBS + b) * 128 + j + 8) * 128 + c);
      else v = ld4bf(B2 + (size_t)(ROWS_P + b * TS + j - 120) * LD2 + 1024 + kv * 128 + c);
      dst = p.out + (kv ? O_VS : O_KS) + (size_t)l * N5 + e2; }
    *(float4*)dst = v;
  }
}

__device__ __forceinline__ void phase_f1(const Params& p, int l, char* sm) {
  constexpr int NPOOL = (NBP * NCH + 16) * 4;
  for (int it = blockIdx.x; it < NUNIT_P + NPOOL; it += gridDim.x) {
    if (it < NUNIT_P) f1_unit(p, l, it, sm);
    else pool_item(p, l, it - NUNIT_P, sm);
  }
  state_copies(p, l, blockIdx.x, gridDim.x);
}
__device__ __forceinline__ void phase_scan(const Params& p, int l, char* sm) {
  if (blockIdx.x < 64) { scan_unit(p, l, blockIdx.x, sm); return; }
  const int nb = gridDim.x - 64, bid = blockIdx.x - 64;
  constexpr int NSWA = NBP * 2 * NCH + NBS * 2;
  for (int it = bid; it < NSWA + NBS * 4; it += nb) {
    if (it < NSWA) swa_item(p, l, it, sm);
    else sample_delta_unit(p, l, it - NSWA, sm);
  }
  __syncthreads();
  phase_gate(p, sm, 0, nb, bid);
}

constexpr int NPHASE = 23;
#define PHASE(k, body) if (ph_lo <= (k) && (k) < ph_hi) { body; if ((k) + 1 < ph_hi) { if ((k) == 0) grid.sync(); else xcd_barrier(xb); } }
constexpr int L_XB = 163824;
__global__ void __launch_bounds__(NTHR, 2) fwd_kernel(Params p, int ph_lo, int ph_hi) {
  extern __shared__ __attribute__((aligned(16))) char sm[];
  cg::grid_group grid = cg::this_grid();
  if (threadIdx.x == 0) { *(volatile LAS unsigned*)(LAS char*)(sm + L_XB) = 0u; *(volatile LAS unsigned*)(LAS char*)(sm + L_XB + 4) = 0u; }
  __syncthreads();
  XcdBarrier xb = xcd_barrier_post((unsigned*)(p.ws + WS_BAR), (volatile LAS unsigned*)(LAS char*)(sm + L_XB));
  PHASE(0, { phase_tables(p); phase_convert(p, 0, sm); phase_norm(p, 0, p.norm1_w, p.w_in + 2560); })
  PHASE(1, phase_p1(p, sm))
  PHASE(2, phase_f1(p, 0, sm))
  PHASE(3, phase_scan(p, 0, sm))
  PHASE(4, { ob_finalize(p, 0); phase_gate(p, sm, 1, gridDim.x, blockIdx.x); })
  PHASE(5, phase_proj(p, sm))
  PHASE(6, phase_out(p, 0, sm))
  PHASE(7, phase_norm(p, 1, p.norm2_w, nullptr, 0, sm))
  PHASE(8, phase_up(p, sm))
  PHASE(9, phase_down(p, sm))
  PHASE(10, { down_reduce(p); phase_convert(p, 1, sm); })
  PHASE(11, phase_norm(p, 1, p.norm1_w + DM, p.w_in + (size_t)DM * D_IN + 2560))
  PHASE(12, phase_p1(p, sm))
  PHASE(13, phase_f1(p, 1, sm))
  PHASE(14, phase_scan(p, 1, sm))
  PHASE(15, { ob_finalize(p, 1); phase_gate(p, sm, 1, gridDim.x, blockIdx.x); })
  PHASE(16, phase_proj(p, sm))
  PHASE(17, phase_out(p, 1, sm))
  PHASE(18, phase_norm(p, 1, p.norm2_w + DM, nullptr, 1, sm))
  PHASE(19, phase_up(p, sm))
  PHASE(20, phase_down(p, sm))
  PHASE(21, down_reduce(p))
  PHASE(22, phase_final(p))
}

extern "C" void kernel_launch(void* const* d_in, const int* in_sizes, int n_in, void* d_out, int out_size, void* d_ws,
                              size_t ws_size, hipStream_t stream) {
  static int grid_blocks = 0;
  if (!grid_blocks) {
    hipFuncSetAttribute((const void*)fwd_kernel, hipFuncAttributeMaxDynamicSharedMemorySize, LDS_BYTES);
    int dev = 0, cus = 0, per_cu = 0;
    hipGetDevice(&dev);
    hipDeviceGetAttribute(&cus, hipDeviceAttributeMultiprocessorCount, dev);
    hipOccupancyMaxActiveBlocksPerMultiprocessor(&per_cu, fwd_kernel, NTHR, LDS_BYTES);
    if (per_cu < 1) per_cu = 1;
    if (per_cu > 1) per_cu = 1;
    grid_blocks = cus * per_cu;
  }
  Params p;
  memset(&p, 0, sizeof(p));
  const float** pp = (const float**)&p;
  for (int i = 0; i < 25; ++i) pp[i] = (const float*)d_in[i];
  p.out = (float*)d_out;
  p.ws = (char*)d_ws;
  if (ws_size < WS_END) { fprintf(stderr, "ws too small\n"); return; }
  hipMemsetAsync((char*)d_ws + WS_BAR, 0, 16384, stream);
#if ONE_LAUNCH
  int lo = 0, hi = NPHASE;
  void* args[] = {&p, &lo, &hi};
  hipError_t e = hipLaunchCooperativeKernel((const void*)fwd_kernel, dim3(grid_blocks), dim3(NTHR), args, LDS_BYTES, stream);
  if (e != hipSuccess) fprintf(stderr, "cooperative launch failed: %s (grid %d)\n", hipGetErrorString(e), grid_blocks);
#else
  for (int ph = 0; ph < NPHASE; ++ph)
    fwd_kernel<<<grid_blocks, NTHR, LDS_BYTES, stream>>>(p, ph, ph + 1);
#endif
}
```

```cpp
#include <hip/hip_runtime.h>
#include <hip/hip_cooperative_groups.h>
#include <cstdio>
#include <cstring>
namespace cg = cooperative_groups;

typedef unsigned short bfraw;
typedef __attribute__((ext_vector_type(8))) short bf16x8;
typedef __attribute__((ext_vector_type(4))) float f32x4;

#define NTHR 512
#ifndef ONE_LAUNCH
#define ONE_LAUNCH 1
#endif

constexpr int DM = 1024, TP = 8208, SEQ = 8192, NBP = 4, NBS = 128, TS = 8;
constexpr int ROWS_P = NBP * TP;
constexpr int ROWS = ROWS_P + NBS * TS;
constexpr int MP = 34048;
constexpr int D_IN = 6408, DFF = 4096;
constexpr int NCH = 129;
constexpr int NUNIT_P = NBP * NCH * 4;
constexpr int LD1 = 2048, LD2 = 1280;
constexpr float EPS = 1e-6f;

constexpr size_t O_YP = 0;
constexpr size_t O_YS = O_YP + (size_t)NBP * SEQ * DM;
constexpr size_t O_POOLP = O_YS + (size_t)NBS * TS * DM;
constexpr size_t O_CONVP = O_POOLP + 2 * 4 * 15 * 512;
constexpr size_t O_DELTAP = O_CONVP + 2 * 4 * 3 * 1536;
constexpr size_t O_KP = O_DELTAP + 2 * 4 * 4 * 128 * 128;
constexpr size_t O_VP = O_KP + 2 * 4 * 128 * 128;
constexpr size_t O_POOLS = O_VP + 2 * 4 * 128 * 128;
constexpr size_t O_CONVS = O_POOLS + (size_t)2 * 128 * 15 * 512;
constexpr size_t O_DELTAS = O_CONVS + (size_t)2 * 128 * 3 * 1536;
constexpr size_t O_KS = O_DELTAS + (size_t)2 * 128 * 4 * 128 * 128;
constexpr size_t O_VS = O_KS + (size_t)2 * 128 * 128 * 128;

constexpr size_t WS_W = 0;
constexpr int NIN = 3328;
constexpr size_t WE_IN = 0;
constexpr size_t WE_POOL = WE_IN + (size_t)(NIN + 3072) * 1024;
constexpr size_t WE_PA = WE_POOL + 4 * 128 * 128;
constexpr size_t WE_PB = WE_PA + 1024 * 512;
constexpr size_t WE_PC = WE_PB + 1024 * 512;
constexpr size_t WE_OUT = WE_PC + 1024 * 512;
constexpr size_t WE_UP = WE_OUT + 1024 * 1024;
constexpr size_t WE_DOWN = WE_UP + (size_t)4096 * 1024;
constexpr size_t WE_END = WE_DOWN + (size_t)1024 * 4096;
constexpr size_t WS_A = WS_W + WE_END * 2;
constexpr size_t WS_B1 = WS_A + (size_t)MP * 1024 * 2;
constexpr size_t WS_B2 = WS_B1 + (size_t)MP * LD1 * 2;
constexpr size_t WS_OA = WS_B2 + (size_t)MP * LD2 * 2;
constexpr size_t WS_D = WS_OA + (size_t)MP * 512 * 2;
constexpr size_t DUNIT = 36864;
constexpr size_t WS_BA = WS_D + (size_t)NUNIT_P * DUNIT * 2;
constexpr size_t WS_GL = WS_BA + (size_t)MP * 8 * 4;
constexpr size_t WS_ROPE = WS_GL + 2064 * 4 + 1024 - (2064 * 4) % 1024;
constexpr size_t WS_META = WS_ROPE + (size_t)8216 * 32 * 8;
constexpr size_t WS_BAR = WS_META + 64 * 1024 * 4;
constexpr size_t WS_END = WS_BAR + 16384;
constexpr size_t WS_HID = WS_B1;
constexpr size_t WS_M = WS_A;
static_assert((size_t)MP * 2048 * 2 <= (size_t)NUNIT_P * DUNIT * 2, "gates a,b must fit in D");
static_assert(WS_HID + (size_t)MP * 4096 * 2 <= WS_BA, "hid beyond D");
static_assert(WS_END <= (size_t)536870912, "ws too big");

struct Params {
  const float *x_prompt, *x_sample, *state_pool, *state_conv, *state_delta, *cache_k, *cache_v, *meta;
  const float *norm1_w, *w_in, *pool_w, *pool_scale, *conv_w, *a_log, *dt_bias, *onorm_w, *sinks;
  const float *proj_a, *proj_b, *proj_c, *w_out, *norm2_w, *w_up, *w_down, *final_w;
  float* out;
  char* ws;
};

__device__ __forceinline__ bfraw f2bf(float f) { return __builtin_bit_cast(bfraw, (__bf16)f); }
__device__ __forceinline__ float bf2f(bfraw h) { return __uint_as_float(((unsigned)h) << 16); }
typedef __bf16 bf16x2_t __attribute__((ext_vector_type(2)));
__device__ __forceinline__ unsigned pack2(float a, float b) { bf16x2_t v; v[0] = (__bf16)a; v[1] = (__bf16)b; return __builtin_bit_cast(unsigned, v); }
__device__ __forceinline__ float lo2f(unsigned u) { return __uint_as_float(u << 16); }
__device__ __forceinline__ float hi2f(unsigned u) { return __uint_as_float(u & 0xffff0000u); }
__device__ __forceinline__ int opq(int x) { asm volatile("" : "+v"(x)); return x; }
__device__ __forceinline__ float sigmoidf_(float x) { return __builtin_amdgcn_rcpf(1.f + __expf(-x)); }
__device__ __forceinline__ f32x4 mfma16(bf16x8 a, bf16x8 b, f32x4 c) {
  return __builtin_amdgcn_mfma_f32_16x16x32_bf16(a, b, c, 0, 0, 0);
}
__device__ __forceinline__ void unpack8(uint4 v, float* f) {
  f[0] = lo2f(v.x); f[1] = hi2f(v.x); f[2] = lo2f(v.y); f[3] = hi2f(v.y);
  f[4] = lo2f(v.z); f[5] = hi2f(v.z); f[6] = lo2f(v.w); f[7] = hi2f(v.w);
}
__device__ __forceinline__ uint4 pack8(const float* f) {
  uint4 v; v.x = pack2(f[0], f[1]); v.y = pack2(f[2], f[3]); v.z = pack2(f[4], f[5]); v.w = pack2(f[6], f[7]);
  return v;
}

#define LAS __attribute__((address_space(3)))
#define XB_TMO      128
#define XB_XCNT(j)  (256  + 64 * (j))
#define XB_XSUB(j)  (1280 + 64 * (j))
#define XB_XGEN(j)  (2304 + 64 * (j))
#define XB_TOP      3328
#define XB_TOPGEN   3392
#define XCD_BAR_WORDS 3456
#define XB_SPIN_CAP (1u << 18)

__device__ __forceinline__ unsigned xb_ld(unsigned* p)              { return __hip_atomic_load(p, __ATOMIC_RELAXED, __HIP_MEMORY_SCOPE_AGENT); }
__device__ __forceinline__ unsigned xb_add(unsigned* p, unsigned v) { return __hip_atomic_fetch_add(p, v, __ATOMIC_RELAXED, __HIP_MEMORY_SCOPE_AGENT); }
__device__ __forceinline__ unsigned xb_xcc_id() { return (unsigned)__builtin_amdgcn_s_getreg((3 << 11) | 20) & 0xFu; }
#define XB_SPIN(cond, bar) do { unsigned _sp = 0; while (cond) { __builtin_amdgcn_s_sleep(1); \
    if ((++_sp & 255u) == 0u) { if (xb_ld(&(bar)[XB_TMO])) break; if (_sp > XB_SPIN_CAP) { atomicAdd(&(bar)[XB_TMO], 1u); break; } } } } while (0)

struct XcdBarrier {
    unsigned* bar; unsigned x;
    volatile LAS unsigned* st;
};

__device__ __forceinline__ XcdBarrier xcd_barrier_post(unsigned* bar, volatile LAS unsigned* st) {
    XcdBarrier b; b.bar = bar; b.x = xb_xcc_id(); b.st = st;
    if (threadIdx.x == 0) (void)xb_add(&bar[XB_XCNT(b.x)], 1u);
    return b;
}
__device__ __forceinline__ void xcd_barrier_complete(unsigned* bar, unsigned x, unsigned& nloc, unsigned& nx) {
    const unsigned G = gridDim.x * gridDim.y * gridDim.z;
    unsigned sum, cnt, mine, sp = 0u;
    for (;;) {
        sum = 0u; cnt = 0u; mine = 0u;
#pragma unroll
        for (unsigned j = 0; j < 16; ++j) { const unsigned c = xb_ld(&bar[XB_XCNT(j)]); sum += c; cnt += (c > 0u) ? 1u : 0u; mine = (j == x) ? c : mine; }
        if (sum == G) break;
        __builtin_amdgcn_s_sleep(1);
        if ((++sp & 255u) == 0u) { if (xb_ld(&bar[XB_TMO])) break; if (sp > XB_SPIN_CAP) { atomicAdd(&bar[XB_TMO], 1u); break; } }
    }
    nloc = mine > 0u ? mine : 1u; nx = cnt > 0u ? cnt : 1u;
}

__device__ __forceinline__ void xcd_barrier(const XcdBarrier& b) {
    asm volatile("s_waitcnt vmcnt(0)" ::: "memory");
    __syncthreads();
    if (threadIdx.x == 0) {
        unsigned* bar = b.bar;
        __builtin_amdgcn_s_waitcnt(0);
        unsigned nloc = b.st[0], nx = b.st[1];
        if (nloc == 0u) { xcd_barrier_complete(bar, b.x, nloc, nx); b.st[0] = nloc; b.st[1] = nx; }
        const unsigned old = xb_add(&bar[XB_XSUB(b.x)], 1u);
        const unsigned gen = old / nloc;
        if (old + 1u == (gen + 1u) * nloc) {
            __builtin_amdgcn_fence(__ATOMIC_RELEASE, "agent");
            asm volatile("s_waitcnt vmcnt(0)" ::: "memory");
            const unsigned og = xb_add(&bar[XB_TOP], 1u);
            const unsigned tg = og / nx;
            if (og + 1u == (tg + 1u) * nx) xb_add(&bar[XB_TOPGEN], 1u);
            else XB_SPIN(xb_ld(&bar[XB_TOPGEN]) == tg, bar);
            __builtin_amdgcn_fence(__ATOMIC_ACQUIRE, "agent");
            xb_add(&bar[XB_XGEN(b.x)], 1u);
            asm volatile("s_waitcnt vmcnt(0)" ::: "memory");
        } else {
            XB_SPIN(xb_ld(&bar[XB_XGEN(b.x)]) == gen, bar);
            __builtin_amdgcn_fence(__ATOMIC_ACQUIRE, "agent");
            asm volatile("s_waitcnt vmcnt(0)" ::: "memory");
        }
    }
    __syncthreads();
}

__device__ __forceinline__ const float* xsrc0(const Params& p, int r) {
  if (r < ROWS_P) {
    int b = r / TP, t = r - b * TP;
    if (t < 16) return p.meta + (size_t)t * DM;
    return p.x_prompt + ((size_t)b * SEQ + (t - 16)) * DM;
  }
  return p.x_sample + (size_t)(r - ROWS_P) * DM;
}
__device__ __forceinline__ float* resid(const Params& p, int r) {
  if (r < ROWS_P) {
    int b = r / TP, t = r - b * TP;
    if (t < 16) return (float*)(p.ws + WS_META) + (size_t)(b * 16 + t) * DM;
    return p.out + O_YP + ((size_t)b * SEQ + (t - 16)) * DM;
  }
  return p.out + O_YS + (size_t)(r - ROWS_P) * DM;
}
__device__ __forceinline__ int posidx_of_row(int r) {
  if (r < ROWS_P) return r % TP;
  int s = r - ROWS_P;
  if (s >= NBS * TS) return 8215;
  return 8208 + (s & 7);
}

__device__ __forceinline__ void phase_tables(const Params& p) {
  const float invf[32] = {1.000000000e+00f, 7.498942614e-01f, 5.623413324e-01f, 4.216965139e-01f, 3.162277639e-01f, 2.371373773e-01f, 1.778279394e-01f, 1.333521307e-01f, 1.000000015e-01f, 7.498941571e-02f, 5.623413250e-02f, 4.216965288e-02f, 3.162277490e-02f, 2.371373773e-02f, 1.778279431e-02f, 1.333521493e-02f, 9.999999776e-03f, 7.498941850e-03f, 5.623413250e-03f, 4.216964822e-03f, 3.162277630e-03f, 2.371373586e-03f, 1.778279431e-03f, 1.333521446e-03f, 1.000000047e-03f, 7.498942432e-04f, 5.623413017e-04f, 4.216965172e-04f, 3.162277571e-04f, 2.371373703e-04f, 1.778279402e-04f, 1.333521504e-04f};
  float2* tab = (float2*)(p.ws + WS_ROPE);
  for (int i = blockIdx.x * NTHR + opq(threadIdx.x); i < 8216 * 32; i += gridDim.x * NTHR) {
    int pi = i >> 5, f = i & 31;
    int pos = pi < 8208 ? pi : 16384 + (pi - 8208);
    float fr = 1.0f;
#pragma unroll
    for (int k = 0; k < 32; ++k) if (k == f) fr = invf[k];
    float ang = (float)pos * fr;
    double x = (double)ang;
    double kq = rint(x * 0.63661977236758134308);
    double r = fma(-kq, 1.57079632679489655800e+00, x);
    r = fma(-kq, 6.12323399573676603587e-17, r);
    double r2 = r * r;
    double s = r * (1.0 + r2 * (-1.0 / 6 + r2 * (1.0 / 120 + r2 * (-1.0 / 5040 + r2 * (1.0 / 362880 + r2 * (-1.0 / 39916800 + r2 * (1.0 / 6227020800.0)))))));
    double c = 1.0 + r2 * (-0.5 + r2 * (1.0 / 24 + r2 * (-1.0 / 720 + r2 * (1.0 / 40320 + r2 * (-1.0 / 3628800 + r2 * (1.0 / 479001600.0))))));
    int qd = ((int)kq) & 3;
    double cs = (qd == 0) ? c : (qd == 1) ? -s : (qd == 2) ? -c : s;
    double sn = (qd == 0) ? s : (qd == 1) ? c : (qd == 2) ? -s : -c;
    tab[i] = make_float2((float)cs, (float)sn);
  }
}

__host__ __device__ __forceinline__ int perm32(int rho) { const int n = rho >> 4, i = rho & 15; return 8 * (i >> 2) + 4 * n + (i & 3); }
__device__ __forceinline__ int win_map(int s) {
  if (s >= NIN) { int lc = (s & ~31) + perm32(s & 31); return lc - NIN + 3336; }
  const int hb = s >> 6;
  int lc;
  if (hb >= 40 && hb < 50) { const int sg = s & 63; lc = hb * 64 + 16 * (sg >> 5) + (sg & 15) + 32 * ((sg >> 4) & 1); }
  else lc = (s & ~31) + perm32(s & 31);
  if (lc < 2560) return lc;
  if (lc < 3328) return lc + 8;
  if (lc < 3336) return 2560 + (lc - 3328);
  return -1;
}
__device__ __forceinline__ void conv_job(const float* __restrict__ src, int K, int ldsrc, bfraw* __restrict__ dst, int Ndst, int kind,
                         float* tile, int& tbase, const float* __restrict__ ksc) {
  const int tid = opq(threadIdx.x);
  int ntk = K / 64, ntn = Ndst / 64, nt = ntk * ntn;
  int first = (int)((blockIdx.x + gridDim.x - (tbase % gridDim.x)) % gridDim.x);
  for (int t = first; t < nt; t += 2 * gridDim.x) {
    const int t2 = t + gridDim.x;
    const bool has2 = t2 < nt;
    float va[8], vb[8];
    int tnA = t / ntk, tkA = t - tnA * ntk, tnB = 0, tkB = 0;
    {
      int n = tnA * 64 + (tid & 63);
      int sc = (kind == 1) ? win_map(n) : (kind == 2) ? ((n & ~31) + perm32(n & 31)) : n;
#pragma unroll
      for (int i = 0; i < 8; ++i) {
        int kl = (tid >> 6) + i * 8;
        float v = (sc >= 0) ? src[(size_t)(tkA * 64 + kl) * ldsrc + sc] : 0.f;
        if (ksc) v *= ksc[tkA * 64 + kl];
        va[i] = v;
      }
    }
    if (has2) {
      tnB = t2 / ntk; tkB = t2 - tnB * ntk;
      int n = tnB * 64 + (tid & 63);
      int sc = (kind == 1) ? win_map(n) : (kind == 2) ? ((n & ~31) + perm32(n & 31)) : n;
#pragma unroll
      for (int i = 0; i < 8; ++i) {
        int kl = (tid >> 6) + i * 8;
        float v = (sc >= 0) ? src[(size_t)(tkB * 64 + kl) * ldsrc + sc] : 0.f;
        if (ksc) v *= ksc[tkB * 64 + kl];
        vb[i] = v;
      }
    }
#pragma unroll
    for (int i = 0; i < 8; ++i) {
      int kl = (tid >> 6) + i * 8;
      tile[kl * 65 + (tid & 63)] = va[i];
      if (has2) tile[4160 + kl * 65 + (tid & 63)] = vb[i];
    }
    __syncthreads();
    {
      int nl = tid >> 3, kc = tid & 7;
      float f[8];
#pragma unroll
      for (int j = 0; j < 8; ++j) f[j] = tile[(kc * 8 + j) * 65 + nl];
      *(uint4*)(dst + (size_t)(tnA * 64 + nl) * K + tkA * 64 + kc * 8) = pack8(f);
      if (has2) {
#pragma unroll
        for (int j = 0; j < 8; ++j) f[j] = tile[4160 + (kc * 8 + j) * 65 + nl];
        *(uint4*)(dst + (size_t)(tnB * 64 + nl) * K + tkB * 64 + kc * 8) = pack8(f);
      }
    }
    __syncthreads();
  }
  tbase += nt;
}
__device__ __forceinline__ void phase_convert(const Params& p, int l, char* smem) {
  float* tile = (float*)smem;
  bfraw* W = (bfraw*)(p.ws + WS_W);
  int tb = 0;
  conv_job(p.w_up + (size_t)l * 1024 * 4096, 1024, 4096, W + WE_UP, 4096, 2, tile, tb, 0);
  conv_job(p.w_down + (size_t)l * 4096 * 1024, 4096, 1024, W + WE_DOWN, 1024, 0, tile, tb, 0);
  conv_job(p.w_in + (size_t)l * 1024 * D_IN, 1024, D_IN, W + WE_IN, NIN + 3072, 1, tile, tb, 0);
  conv_job(p.w_out + (size_t)l * 1024 * 1024, 1024, 1024, W + WE_OUT, 1024, 0, tile, tb, 0);
  conv_job(p.proj_a + (size_t)l * 512 * 1024, 512, 1024, W + WE_PA, 1024, 2, tile, tb, 0);
  conv_job(p.proj_b + (size_t)l * 512 * 1024, 512, 1024, W + WE_PB, 1024, 2, tile, tb, 0);
  conv_job(p.proj_c + (size_t)l * 512 * 1024, 512, 1024, W + WE_PC, 1024, 2, tile, tb, 0);
  for (int g = 0; g < 4; ++g)
    conv_job(p.pool_w + (size_t)(l * 4 + g) * 128 * 128, 128, 128, W + WE_POOL + g * 128 * 128, 128, 0, tile, tb, 0);
}

__device__ __forceinline__ void phase_final(const Params& p) {
  const int lane = opq(threadIdx.x) & 63, w = opq(threadIdx.x) >> 6;
  float4 wv[4];
#pragma unroll
  for (int j = 0; j < 4; ++j) wv[j] = *(const float4*)(p.final_w + j * 256 + lane * 4);
  for (int r = blockIdx.x * 8 + w; r < ROWS; r += gridDim.x * 8) {
    if (r < ROWS_P && (r % TP) < 16) continue;
    float* src = resid(p, r);
    float4 v[4];
    float ss = 0.f;
#pragma unroll
    for (int j = 0; j < 4; ++j) {
      v[j] = *(const float4*)(src + j * 256 + lane * 4);
      ss += v[j].x * v[j].x + v[j].y * v[j].y + v[j].z * v[j].z + v[j].w * v[j].w;
    }
#pragma unroll
    for (int o = 32; o >= 1; o >>= 1) ss += __shfl_xor(ss, o);
    float rinv = rsqrtf(ss * (1.f / 1024.f) + EPS);
#pragma unroll
    for (int j = 0; j < 4; ++j) {
      float4 o4 = make_float4(v[j].x * rinv * wv[j].x, v[j].y * rinv * wv[j].y, v[j].z * rinv * wv[j].z, v[j].w * rinv * wv[j].w);
      *(float4*)(src + j * 256 + lane * 4) = o4;
    }
  }
}

namespace g8 {
constexpr int BM = 256, BK = 64, HALF = 128, HTB = HALF * BK * 2, STAGE_BYTES = 8 * HTB, NXCD = 8, WGM = 8;
__device__ __forceinline__ int lds_byte(int r, int c) { const int st = (r >> 4) * 2 + (c >> 5), rr = r & 15, cc = c & 31, ob = rr * 64 + cc * 2; return st * 1024 + (ob ^ (((ob >> 9) & 1) << 5)); }
__device__ __forceinline__ void stage_rc(int b, int& R, int& C) { const int st = b / 1024, sb = b % 1024, swz = sb ^ (((sb >> 9) & 1) << 5); R = (st >> 1) * 16 + swz / 64; C = (st & 1) * 32 + (swz % 64) / 2; }
struct Unit { int pm, pn, koff, seq; };
struct Gemm { const bfraw* A; const bfraw* Bt; int M, N, K, lda, ldb; };
struct StaticOrder {
  int nM, nN, nwg, G, c, t0, cnt, ks, klen;
  __device__ void init(int M, int N, int G_, int c_) { nM = M / BM; nN = N / BM; nwg = nM * nN; G = G_; c = c_; t0 = 0; cnt = nwg; ks = 1; klen = 0; }
  __device__ void sub(int first, int ntiles, int ks_, int klen_) { t0 = first; cnt = ntiles * ks_; ks = ks_; klen = klen_; }
  __device__ bool next(int i, Unit& u) const {
    const long L = (long)i * G + c; if (L >= cnt) return false;
    int wgid = t0 + (int)L / ks; u.koff = ((int)L % ks) * klen; u.seq = (int)L;
    { const int q = nwg / NXCD, r = nwg % NXCD, xcd = wgid % NXCD, off = wgid / NXCD; wgid = (xcd < r ? xcd * (q + 1) : r * (q + 1) + (xcd - r) * q) + off; }
    const int nig = WGM * nN, gid = wgid / nig, fm = gid * WGM, gsz = (nM - fm) < WGM ? (nM - fm) : WGM;
    u.pm = fm + ((wgid % nig) % gsz); u.pn = (wgid % nig) / gsz; return true;
  }
};

struct GateOrder {
  int part, G, c;
  __device__ bool next(int i, Unit& u) const {
    const int L = i * G + c; u.koff = 0; u.seq = L;
    if (part == 0) { if (L >= 384) return false; u.pm = L / 3; u.pn = L - u.pm * 3; return true; }
    if (L >= 1212) return false;
    if (L < 1152) { u.pm = L / 9; u.pn = 3 + (L - u.pm * 9); }
    else { const int L2 = L - 1152; u.pm = 128 + L2 / 12; u.pn = L2 % 12; }
    return true;
  }
};

template <class Epi, class Sched>
__device__ __forceinline__ void gemm_phase(LAS unsigned char* lds, const Gemm g, const Sched& S, const Epi& E) {
  const int tid = opq(threadIdx.x), wid = __builtin_amdgcn_readfirstlane(tid >> 6), lane = tid & 63, wr = wid >> 2, wc = wid & 3, fr = lane & 15, fq = lane >> 4;
  const int K = g.K, nt = K / BK;
  unsigned voffA[2], voffB[2];
#pragma unroll
  for (int i = 0; i < 2; ++i) { int R, C; stage_rc(tid * 16 + i * 8192, R, C);
    voffA[i] = (unsigned)(R * g.lda + C) * 2u; voffB[i] = (unsigned)(R * g.ldb + C) * 2u; }
  const size_t kstep = (size_t)(BK * 2);
  const size_t hstepA = (size_t)HALF * g.lda * 2, hstepB = (size_t)HALF * g.ldb * 2;
  const size_t tstepA = 2 * hstepA, tstepB = 2 * hstepB;
  const unsigned ldsw = (unsigned)wid * 1024u;
  const int aoff = lds_byte(wr * 64 + fr, fq * 8), boff = lds_byte(wc * 32 + fr, fq * 8);
#define G8_SA(b, h) (((b) * 2 + (h)) * HTB)
#define G8_SB(b, h) ((4 + (b) * 2 + (h)) * HTB)
#define G8_STAGE(bufoff, gbase, voff) do { _Pragma("unroll") for (int _i = 0; _i < 2; ++_i) \
    __builtin_amdgcn_global_load_lds((const unsigned*)((const char*)(gbase) + (voff)[_i]), (LAS unsigned*)(lds + (bufoff) + ldsw + _i * 8192), 16, 0, 0); } while (0)
#define G8_LDA(dst, b, h) do { _Pragma("unroll") for (int m = 0; m < 4; ++m) _Pragma("unroll") for (int k = 0; k < 2; ++k) dst[m][k] = *(const LAS bf16x8*)(lds + G8_SA(b, h) + aoff + m * 2048 + k * 1024); } while (0)
#define G8_LDB(dst, b, h) do { _Pragma("unroll") for (int n = 0; n < 2; ++n) _Pragma("unroll") for (int k = 0; k < 2; ++k) dst[n][k] = *(const LAS bf16x8*)(lds + G8_SB(b, h) + boff + n * 2048 + k * 1024); } while (0)
#define G8_MMA(ai, bj, At, Bt) do { __builtin_amdgcn_s_setprio(1); _Pragma("unroll") for (int m = 0; m < 4; ++m) _Pragma("unroll") for (int n = 0; n < 2; ++n) _Pragma("unroll") for (int k = 0; k < 2; ++k) \
    acc[ai][bj][m][n] = __builtin_amdgcn_mfma_f32_16x16x32_bf16(Bt[n][k], At[m][k], acc[ai][bj][m][n], 0, 0, 0); __builtin_amdgcn_s_setprio(0); } while (0)
#define G8_WAIT_V(n) asm volatile("s_waitcnt vmcnt(" #n ")" ::: "memory")
#define G8_WAIT_L(n) asm volatile("s_waitcnt lgkmcnt(" #n ")" ::: "memory")
#define G8_BAR __builtin_amdgcn_s_barrier()
#define G8_SCHED __builtin_amdgcn_sched_barrier(0)
  Unit cur, nxt; int ui = 0;
  if (!S.next(0, cur)) return;
  f32x4 acc[2][2][4][2];
#pragma unroll
  for (int a = 0; a < 2; ++a)
#pragma unroll
    for (int b = 0; b < 2; ++b)
#pragma unroll
      for (int m = 0; m < 4; ++m)
#pragma unroll
        for (int n = 0; n < 2; ++n) acc[a][b][m][n] = (f32x4){0.f, 0.f, 0.f, 0.f};
  bf16x8 At[4][2], B0[2][2], B1[2][2];
  const char* cA = (const char*)g.A + (size_t)cur.pm * tstepA + (size_t)cur.koff * 2; const char* cB = (const char*)g.Bt + (size_t)cur.pn * tstepB + (size_t)cur.koff * 2;
  G8_STAGE(G8_SB(0, 0), cB, voffB); G8_STAGE(G8_SA(0, 0), cA, voffA); G8_STAGE(G8_SB(0, 1), cB + hstepB, voffB); G8_STAGE(G8_SA(0, 1), cA + hstepA, voffA);
  if (wr == 1) G8_BAR;
  G8_WAIT_V(4); G8_BAR;
  G8_STAGE(G8_SB(1, 0), cB + kstep, voffB); G8_STAGE(G8_SA(1, 0), cA + kstep, voffA); G8_STAGE(G8_SB(1, 1), cB + hstepB + kstep, voffB);
  G8_WAIT_V(6); G8_BAR;
  for (;;) {
    const bool has_next = S.next(ui + 1, nxt);
    const char* nA = has_next ? (const char*)g.A + (size_t)nxt.pm * tstepA + (size_t)nxt.koff * 2 : cA; const char* nB = has_next ? (const char*)g.Bt + (size_t)nxt.pn * tstepB + (size_t)nxt.koff * 2 : cB;
    for (int t = 0; t < nt; t += 2) {
      const bool last = (t == nt - 2);
      const char* a1 = cA + (size_t)(t + 1) * kstep;
      const char* a2 = last ? nA : cA + (size_t)(t + 2) * kstep; const char* b2 = last ? nB : cB + (size_t)(t + 2) * kstep;
      const char* a3 = a2 + kstep; const char* b3 = b2 + kstep;
      G8_LDB(B0, 0, 0); G8_SCHED; G8_LDA(At, 0, 0); G8_STAGE(G8_SA(1, 1), a1 + hstepA, voffA);
      G8_WAIT_L(8); G8_BAR; G8_WAIT_L(0); G8_MMA(0, 0, At, B0); G8_BAR; G8_SCHED;
      G8_LDB(B1, 0, 1); G8_STAGE(G8_SB(0, 0), b2, voffB);
      G8_BAR; G8_WAIT_L(0); G8_MMA(0, 1, At, B1); G8_BAR;
      G8_LDA(At, 0, 1); G8_STAGE(G8_SA(0, 0), a2, voffA);
      G8_BAR; G8_WAIT_L(0); G8_MMA(1, 0, At, B0); G8_BAR; G8_SCHED;
      G8_STAGE(G8_SB(0, 1), b2 + hstepB, voffB);
      G8_WAIT_V(6); G8_BAR; G8_MMA(1, 1, At, B1); G8_BAR;
      G8_LDB(B0, 1, 0); G8_SCHED; G8_LDA(At, 1, 0); G8_STAGE(G8_SA(0, 1), a2 + hstepA, voffA);
      G8_WAIT_L(8); G8_BAR; G8_WAIT_L(0); G8_MMA(0, 0, At, B0); G8_BAR; G8_SCHED;
      G8_LDB(B1, 1, 1); G8_STAGE(G8_SB(1, 0), b3, voffB);
      G8_BAR; G8_WAIT_L(0); G8_MMA(0, 1, At, B1); G8_BAR;
      G8_LDA(At, 1, 1); G8_STAGE(G8_SA(1, 0), a3, voffA);
      G8_BAR; G8_WAIT_L(0); G8_MMA(1, 0, At, B0); G8_BAR; G8_SCHED;
      G8_STAGE(G8_SB(1, 1), b3 + hstepB, voffB);
      G8_WAIT_V(6); G8_BAR; G8_MMA(1, 1, At, B1); G8_BAR;
    }
    E(acc, cur, wr, wc, fr, fq);
    if (!has_next) break;
#pragma unroll
    for (int a = 0; a < 2; ++a)
#pragma unroll
      for (int b = 0; b < 2; ++b)
#pragma unroll
        for (int m = 0; m < 4; ++m)
#pragma unroll
          for (int n = 0; n < 2; ++n) acc[a][b][m][n] = (f32x4){0.f, 0.f, 0.f, 0.f};
    cur = nxt; cA = nA; cB = nB; ++ui;
  }
  G8_WAIT_V(0);
  if (wr == 0) G8_BAR;
  G8_BAR;
#undef G8_SA
#undef G8_SB
#undef G8_STAGE
#undef G8_LDA
#undef G8_LDB
#undef G8_MMA
#undef G8_WAIT_V
#undef G8_WAIT_L
#undef G8_BAR
#undef G8_SCHED
}
}

__device__ __forceinline__ void phase_norm(const Params& p, int mode, const float* __restrict__ nw, const float* __restrict__ wba,
                                           int tail_l = -1, char* sm = nullptr) {
  const int lane = opq(threadIdx.x) & 63, w = opq(threadIdx.x) >> 6;
  signed char* tt = (signed char*)sm;
  if (tail_l >= 0) {
    for (int i = opq(threadIdx.x); i < 133 * 4; i += NTHR) tt[i] = -1;
    __syncthreads();
    if (opq(threadIdx.x) < 20) {
      g8::StaticOrder S; S.init(MP, 1024, 1, 0); S.sub(512, 20, 1, 0);
      g8::Unit u; S.next(opq(threadIdx.x), u);
      tt[u.pm * 4 + u.pn] = (signed char)opq(threadIdx.x);
    }
    __syncthreads();
  }
  const float* PSo = (const float*)(p.ws + WS_D);
  bfraw* A = (bfraw*)(p.ws + WS_A);
  float* BA = (float*)(p.ws + WS_BA);
  float4 wv[4];
#pragma unroll
  for (int j = 0; j < 4; ++j) wv[j] = *(const float4*)(nw + j * 256 + lane * 4);
  float wq[16][8];
  if (wba) {
#pragma unroll
    for (int j = 0; j < 4; ++j)
#pragma unroll
      for (int e = 0; e < 4; ++e) {
        const int k = j * 256 + lane * 4 + e;
        const float nwk = (e == 0) ? wv[j].x : (e == 1) ? wv[j].y : (e == 2) ? wv[j].z : wv[j].w;
        const float4 a = *(const float4*)(wba + (size_t)k * D_IN), b = *(const float4*)(wba + (size_t)k * D_IN + 4);
        wq[j * 4 + e][0] = a.x * nwk; wq[j * 4 + e][1] = a.y * nwk; wq[j * 4 + e][2] = a.z * nwk; wq[j * 4 + e][3] = a.w * nwk;
        wq[j * 4 + e][4] = b.x * nwk; wq[j * 4 + e][5] = b.y * nwk; wq[j * 4 + e][6] = b.z * nwk; wq[j * 4 + e][7] = b.w * nwk;
      }
  }
  for (int r = blockIdx.x * 8 + w; r < MP; r += gridDim.x * 8) {
    bfraw* dst = A + (size_t)r * DM;
    if (r >= ROWS) {
#pragma unroll
      for (int j = 0; j < 4; ++j) *(uint2*)(dst + j * 256 + lane * 4) = make_uint2(0u, 0u);
      continue;
    }
    const float* src = mode ? (const float*)resid(p, r) : xsrc0(p, r);
    float4 v[4];
    float ss = 0.f;
#pragma unroll
    for (int j = 0; j < 4; ++j) {
      v[j] = *(const float4*)(src + j * 256 + lane * 4);
      if (tail_l >= 0) {
        const int t = tt[(r >> 8) * 4 + j];
        if (t >= 0) {
          if (tail_l == 0) v[j] = *(const float4*)(xsrc0(p, r) + j * 256 + lane * 4);
#pragma unroll
          for (int k = 0; k < 4; ++k) {
            const float4 a = *(const float4*)(PSo + (size_t)(t * 4 + k) * 65536 + (r & 255) * 256 + lane * 4);
            v[j].x += a.x; v[j].y += a.y; v[j].z += a.z; v[j].w += a.w;
          }
          *(float4*)(resid(p, r) + j * 256 + lane * 4) = v[j];
        }
      }
      ss += v[j].x * v[j].x + v[j].y * v[j].y + v[j].z * v[j].z + v[j].w * v[j].w;
    }
#pragma unroll
    for (int o = 32; o >= 1; o >>= 1) ss += __shfl_xor(ss, o);
    float rinv = rsqrtf(ss * (1.f / 1024.f) + EPS);
#pragma unroll
    for (int j = 0; j < 4; ++j) {
      uint2 o2;
      o2.x = pack2(v[j].x * rinv * wv[j].x, v[j].y * rinv * wv[j].y);
      o2.y = pack2(v[j].z * rinv * wv[j].z, v[j].w * rinv * wv[j].w);
      *(uint2*)(dst + j * 256 + lane * 4) = o2;
    }
    if (wba) {
      float d[8];
#pragma unroll
      for (int c = 0; c < 8; ++c) {
        float s = 0.f;
#pragma unroll
        for (int j = 0; j < 4; ++j)
          s += v[j].x * wq[j * 4 + 0][c] + v[j].y * wq[j * 4 + 1][c] + v[j].z * wq[j * 4 + 2][c] + v[j].w * wq[j * 4 + 3][c];
#pragma unroll
        for (int o = 32; o >= 1; o >>= 1) s += __shfl_xor(s, o);
        d[c] = s * rinv;
      }
      if (lane == 0) {
        *(float4*)(BA + (size_t)r * 8) = make_float4(d[0], d[1], d[2], d[3]);
        *(float4*)(BA + (size_t)r * 8 + 4) = make_float4(d[4], d[5], d[6], d[7]);
      }
    }
  }
}
__device__ __forceinline__ uint4 pack8v(f32x4 a, f32x4 b) {
  uint4 v; v.x = pack2(a[0], a[1]); v.y = pack2(a[2], a[3]); v.z = pack2(b[0], b[1]); v.w = pack2(b[2], b[3]); return v;
}

struct EpiP1 {
  bfraw* B1; bfraw* B2; float* BA; const float2* tab;
  __device__ __forceinline__ void operator()(const f32x4 (&acc)[2][2][4][2], const g8::Unit& u, int wr, int wc, int fr, int fq) const {
    const int pn = u.pn;
#pragma unroll
    for (int ai = 0; ai < 2; ++ai)
#pragma unroll
      for (int m = 0; m < 4; ++m) {
        const int row = u.pm * 256 + ai * 128 + wr * 64 + m * 16 + fr;
        int pi = 0;
        if (pn >= 10 && pn <= 12) pi = posidx_of_row(row);
#pragma unroll
        for (int bj = 0; bj < 2; ++bj) {
          const f32x4 v0 = acc[ai][bj][m][0], v1 = acc[ai][bj][m][1];
          const int lc0 = pn * 256 + bj * 128 + wc * 32;
          if (pn < 8) {
            *(uint4*)(B1 + (size_t)row * LD1 + lc0 + 8 * fq) = pack8v(v0, v1);
          } else if (pn < 10 || (pn == 12 && bj == 1)) {
            *(uint4*)(B2 + (size_t)row * LD2 + (lc0 - 2048) + 8 * fq) = pack8v(v0, v1);
          } else if (pn < 13) {
            const int hb = lc0 & ~63;
            const int d0 = 16 * (wc & 1) + 4 * fq;
            const float sc = (pn < 12) ? 0.125f : 1.0f;
            float o1[4], o2[4];
#pragma unroll
            for (int j = 0; j < 4; ++j) {
              const float2 cs = tab[pi * 32 + d0 + j];
              o1[j] = (v0[j] * cs.x - v1[j] * cs.y) * sc;
              o2[j] = (v1[j] * cs.x + v0[j] * cs.y) * sc;
            }
            uint2 w1, w2;
            w1.x = pack2(o1[0], o1[1]); w1.y = pack2(o1[2], o1[3]);
            w2.x = pack2(o2[0], o2[1]); w2.y = pack2(o2[2], o2[3]);
            bfraw* dst = B2 + (size_t)row * LD2 + (hb - 2048) + d0;
            *(uint2*)dst = w1;
            *(uint2*)(dst + 32) = w2;
          } else {
            if (bj == 0 && wc == 0 && fq == 0) {
              *(f32x4*)(BA + (size_t)row * 8) = v0;
              *(f32x4*)(BA + (size_t)row * 8 + 4) = v1;
            }
          }
        }
      }
  }
};
template <int ACT> struct EpiAct {
  bfraw* O0; bfraw* O1; int ldc; int split;
  __device__ __forceinline__ void operator()(const f32x4 (&acc)[2][2][4][2], const g8::Unit& u, int wr, int wc, int fr, int fq) const {
#pragma unroll
    for (int ai = 0; ai < 2; ++ai)
#pragma unroll
      for (int m = 0; m < 4; ++m) {
        const int row = u.pm * 256 + ai * 128 + wr * 64 + m * 16 + fr;
#pragma unroll
        for (int bj = 0; bj < 2; ++bj) {
          f32x4 v0 = acc[ai][bj][m][0], v1 = acc[ai][bj][m][1];
#pragma unroll
          for (int j = 0; j < 4; ++j) {
            if (ACT == 1) { v0[j] = sigmoidf_(v0[j]); v1[j] = sigmoidf_(v1[j]); }
            else { float a = fmaxf(v0[j], 0.f), b = fmaxf(v1[j], 0.f); v0[j] = a * a; v1[j] = b * b; }
          }
          const int c = u.pn * 256 + bj * 128 + wc * 32 + 8 * fq;
          bfraw* dst = (c < split) ? (O0 + (size_t)row * ldc + c) : (O1 + (size_t)row * ldc + (c - split));
          *(uint4*)dst = pack8v(v0, v1);
        }
      }
  }
};
struct EpiProj {
  bfraw* M; const bfraw* G0; const bfraw* G1; int csplit; int first;
  __device__ __forceinline__ void operator()(const f32x4 (&acc)[2][2][4][2], const g8::Unit& u, int wr, int wc, int fr, int fq) const {
#pragma unroll
    for (int ai = 0; ai < 2; ++ai) {
      uint4 gq[8], mq[8];
#pragma unroll
      for (int m = 0; m < 4; ++m) {
        const int row = u.pm * 256 + ai * 128 + wr * 64 + m * 16 + fr;
#pragma unroll
        for (int bj = 0; bj < 2; ++bj) {
          const int c = u.pn * 256 + bj * 128 + wc * 32 + 8 * fq;
          const bfraw* G = (c < csplit) ? G0 : G1;
          gq[m * 2 + bj] = *(const uint4*)(G + (size_t)row * 2048 + c);
          if (!first) mq[m * 2 + bj] = *(const uint4*)(M + (size_t)row * DM + c);
          else mq[m * 2 + bj] = make_uint4(0u, 0u, 0u, 0u);
        }
      }
#pragma unroll
      for (int m = 0; m < 4; ++m) {
        const int row = u.pm * 256 + ai * 128 + wr * 64 + m * 16 + fr;
#pragma unroll
        for (int bj = 0; bj < 2; ++bj) {
          const int c = u.pn * 256 + bj * 128 + wc * 32 + 8 * fq;
          float gv[8], mv[8];
          unpack8(gq[m * 2 + bj], gv);
          unpack8(mq[m * 2 + bj], mv);
          const f32x4 v0 = acc[ai][bj][m][0], v1 = acc[ai][bj][m][1];
#pragma unroll
          for (int j = 0; j < 4; ++j) { mv[j] += gv[j] * v0[j]; mv[4 + j] += gv[4 + j] * v1[j]; }
          *(uint4*)(M + (size_t)row * DM + c) = pack8(mv);
        }
      }
    }
  }
};
struct EpiResid {
  const Params* p; int from_input; int atomic;
  __device__ __forceinline__ void operator()(const f32x4 (&acc)[2][2][4][2], const g8::Unit& u, int wr, int wc, int fr, int fq) const {
#pragma unroll
    for (int ai = 0; ai < 2; ++ai) {
      f32x4 xq[4][2][2];
#pragma unroll
      for (int m = 0; m < 4; ++m) {
        const int row = u.pm * 256 + ai * 128 + wr * 64 + m * 16 + fr;
        const int rr = row < ROWS ? row : ROWS - 1;
        const float* xs = from_input ? xsrc0(*p, rr) : (const float*)resid(*p, rr);
#pragma unroll
        for (int bj = 0; bj < 2; ++bj)
#pragma unroll
          for (int n = 0; n < 2; ++n) {
            const int c = u.pn * 256 + bj * 128 + wc * 32 + 16 * n + 4 * fq;
            xq[m][bj][n] = *(const f32x4*)(xs + c);
          }
      }
#pragma unroll
      for (int m = 0; m < 4; ++m) {
        const int row = u.pm * 256 + ai * 128 + wr * 64 + m * 16 + fr;
        if (row < ROWS) {
          float* xd = resid(*p, row);
#pragma unroll
          for (int bj = 0; bj < 2; ++bj)
#pragma unroll
            for (int n = 0; n < 2; ++n) {
              const int c = u.pn * 256 + bj * 128 + wc * 32 + 16 * n + 4 * fq;
              *(f32x4*)(xd + c) = xq[m][bj][n] + acc[ai][bj][m][n];
            }
        }
      }
    }
  }
};

struct EpiPart {
  float* PS; int tile0; int ks;
  __device__ __forceinline__ void operator()(const f32x4 (&acc)[2][2][4][2], const g8::Unit& u, int wr, int wc, int fr, int fq) const {
    float* base = PS + (size_t)(u.seq) * 65536;
#pragma unroll
    for (int ai = 0; ai < 2; ++ai)
#pragma unroll
      for (int m = 0; m < 4; ++m) {
        const int rl = ai * 128 + wr * 64 + m * 16 + fr;
#pragma unroll
        for (int bj = 0; bj < 2; ++bj)
#pragma unroll
          for (int n = 0; n < 2; ++n) {
            const int c = bj * 128 + wc * 32 + 16 * n + 4 * fq;
            *(f32x4*)(base + rl * 256 + c) = acc[ai][bj][m][n];
          }
      }
  }
};
__device__ __forceinline__ void phase_p1(const Params& p, char* sm) {
  g8::Gemm g{(const bfraw*)(p.ws + WS_A), (const bfraw*)(p.ws + WS_W) + WE_IN, MP, NIN, DM, DM, DM};
  g8::StaticOrder S; S.init(MP, NIN, gridDim.x, blockIdx.x);
  EpiP1 E{(bfraw*)(p.ws + WS_B1), (bfraw*)(p.ws + WS_B2), (float*)(p.ws + WS_BA), (const float2*)(p.ws + WS_ROPE)};
  g8::gemm_phase(( LAS unsigned char*)sm, g, S, E);
}
__device__ __forceinline__ void phase_gate(const Params& p, char* sm, int part, int G, int c) {
  g8::Gemm g{(const bfraw*)(p.ws + WS_A), (const bfraw*)(p.ws + WS_W) + WE_IN + (size_t)NIN * DM, MP, 3072, DM, DM, DM};
  g8::GateOrder S{part, G, c};
  EpiAct<1> E{(bfraw*)(p.ws + WS_B1) + 512, (bfraw*)(p.ws + WS_D), 2048, 1536};
  g8::gemm_phase((LAS unsigned char*)sm, g, S, E);
}
__device__ __forceinline__ void phase_proj(const Params& p, char* sm) {
  const bfraw* W = (const bfraw*)(p.ws + WS_W);
  const bfraw* GB = (const bfraw*)(p.ws + WS_B1) + 512;
  const bfraw* GD = (const bfraw*)(p.ws + WS_D);
  g8::StaticOrder S; S.init(MP, 1024, gridDim.x, blockIdx.x);
  {
    g8::Gemm g{(const bfraw*)(p.ws + WS_OA), W + WE_PA, MP, 1024, 512, 512, 512};
    EpiProj E{(bfraw*)(p.ws + WS_M), GB, GB, 1024, 1};
    g8::gemm_phase((LAS unsigned char*)sm, g, S, E);
  }
  {
    g8::Gemm g{(const bfraw*)(p.ws + WS_B1), W + WE_PB, MP, 1024, 512, LD1, 512};
    EpiProj E{(bfraw*)(p.ws + WS_M), GB + 1024, GD - 512, 512, 0};
    g8::gemm_phase((LAS unsigned char*)sm, g, S, E);
  }
  {
    g8::Gemm g{(const bfraw*)(p.ws + WS_B2) + 512, W + WE_PC, MP, 1024, 512, LD2, 512};
    EpiProj E{(bfraw*)(p.ws + WS_M), GD + 512, GD + 512, 0, 0};
    g8::gemm_phase((LAS unsigned char*)sm, g, S, E);
  }
}
constexpr int OUT_FULL = 512, OUT_TAIL = 20, OUT_KS = 4;
__device__ __forceinline__ void phase_out(const Params& p, int l, char* sm) {
  {
    g8::Gemm g{(const bfraw*)(p.ws + WS_M), (const bfraw*)(p.ws + WS_W) + WE_OUT, MP, 1024, DM, DM, DM};
    g8::StaticOrder S; S.init(MP, 1024, gridDim.x, blockIdx.x); S.sub(0, OUT_FULL, 1, 0);
    EpiResid E{&p, l == 0 ? 1 : 0, 0};
    g8::gemm_phase((LAS unsigned char*)sm, g, S, E);
  }
  {
    g8::Gemm g{(const bfraw*)(p.ws + WS_M), (const bfraw*)(p.ws + WS_W) + WE_OUT, MP, 1024, DM / OUT_KS, DM, DM};
    g8::StaticOrder S; S.init(MP, 1024, gridDim.x, blockIdx.x); S.sub(OUT_FULL, OUT_TAIL, OUT_KS, DM / OUT_KS);
    EpiPart E{(float*)(p.ws + WS_D), OUT_FULL, OUT_KS};
    g8::gemm_phase((LAS unsigned char*)sm, g, S, E);
  }
}
__device__ __forceinline__ void phase_up(const Params& p, char* sm) {
  g8::Gemm g{(const bfraw*)(p.ws + WS_A), (const bfraw*)(p.ws + WS_W) + WE_UP, MP, DFF, DM, DM, DM};
  g8::StaticOrder S; S.init(MP, DFF, gridDim.x, blockIdx.x);
  EpiAct<2> E{(bfraw*)(p.ws + WS_HID), (bfraw*)(p.ws + WS_HID), DFF, 1 << 30};
  g8::gemm_phase((LAS unsigned char*)sm, g, S, E);
}
constexpr int DOWN_FULL = 512, DOWN_TAIL = 20, DOWN_KS = 8;
__device__ __forceinline__ void phase_down(const Params& p, char* sm) {
  {
    g8::Gemm g{(const bfraw*)(p.ws + WS_HID), (const bfraw*)(p.ws + WS_W) + WE_DOWN, MP, 1024, DFF, DFF, DFF};
    g8::StaticOrder S; S.init(MP, 1024, gridDim.x, blockIdx.x); S.sub(0, DOWN_FULL, 1, 0);
    EpiResid E{&p, 0, 0};
    g8::gemm_phase((LAS unsigned char*)sm, g, S, E);
  }
  {
    g8::Gemm g{(const bfraw*)(p.ws + WS_HID), (const bfraw*)(p.ws + WS_W) + WE_DOWN, MP, 1024, DFF / DOWN_KS, DFF, DFF};
    g8::StaticOrder S; S.init(MP, 1024, gridDim.x, blockIdx.x); S.sub(DOWN_FULL, DOWN_TAIL, DOWN_KS, DFF / DOWN_KS);
    EpiPart E{(float*)(p.ws + WS_A), DOWN_FULL, DOWN_KS};
    g8::gemm_phase((LAS unsigned char*)sm, g, S, E);
  }
}
__device__ __forceinline__ void down_reduce(const Params& p) {
  const float* PS = (const float*)(p.ws + WS_A);
  g8::StaticOrder S; S.init(MP, 1024, 1, 0); S.sub(DOWN_FULL, DOWN_TAIL, 1, 0);
  for (int i = blockIdx.x * NTHR + opq(threadIdx.x); i < DOWN_TAIL * 16384; i += gridDim.x * NTHR) {
    const int t = i >> 14, e = i & 16383, rl = e >> 6, c4 = (e & 63) * 4;
    g8::Unit u; S.next(t, u);
    const int row = u.pm * 256 + rl;
    if (row >= ROWS) continue;
    f32x4 s = (f32x4){0.f, 0.f, 0.f, 0.f};
#pragma unroll
    for (int k = 0; k < DOWN_KS; ++k) s += *(const f32x4*)(PS + (size_t)(t * DOWN_KS + k) * 65536 + rl * 256 + c4);
    float* xd = resid(p, row) + u.pn * 256 + c4;
    *(f32x4*)xd = *(const f32x4*)xd + s;
  }
}

__device__ __forceinline__ void pool_item(const Params& p, int l, int it, char* smem_c) {
  const int tid = opq(threadIdx.x), lane = tid & 63, w = tid >> 6, r = lane & 15, q = lane >> 4;
  bfraw* dA = (bfraw*)smem_c;
  bfraw* sW = (bfraw*)(smem_c + 64 * 136 * 2);
  bfraw* U = (bfraw*)(smem_c + 52224);
  const bfraw* B1 = (const bfraw*)(p.ws + WS_B1);
  bfraw* OA = (bfraw*)(p.ws + WS_OA);
  const int rt = it >> 2, g = it & 3;
  int grow0, nrows, t0 = 0;
  const bool isP = rt < NBP * NCH;
  if (isP) { int b = rt / NCH, i = rt - b * NCH; t0 = i * 64; nrows = min(64, TP - t0); grow0 = b * TP + t0; }
  else { grow0 = ROWS_P + (rt - NBP * NCH) * 64; nrows = 64; }
  const int wnd = 2 << g;
  {
    uint4 sv[6];
    const int nch = isP ? 79 * 16 : 184 * 16;
#pragma unroll
    for (int i = 0; i < 6; ++i) {
      const int c = tid + i * NTHR;
      uint4 v = make_uint4(0u, 0u, 0u, 0u);
      if (c < nch) {
        const int rr = c >> 4, ch = c & 15;
        if (isP) {
          const int t = t0 - 15 + rr;
          if (t >= 0 && t < TP) v = *(const uint4*)(B1 + (size_t)(grow0 - 15 + rr) * LD1 + g * 128 + ch * 8);
        } else {
          const int sg = rr / 23, pp = rr - sg * 23;
          const int bb = ((grow0 - ROWS_P) >> 3) + sg;
          if (pp < 15) {
            const float* s = p.state_pool + ((size_t)(l * NBS + bb) * 15 + pp) * 512 + g * 128 + ch * 8;
            float4 f0 = *(const float4*)s, f1 = *(const float4*)(s + 4);
            v.x = pack2(f0.x, f0.y); v.y = pack2(f0.z, f0.w); v.z = pack2(f1.x, f1.y); v.w = pack2(f1.z, f1.w);
          } else v = *(const uint4*)(B1 + (size_t)(ROWS_P + bb * TS + pp - 15) * LD1 + g * 128 + ch * 8);
        }
      }
      sv[i] = v;
    }
#pragma unroll
    for (int i = 0; i < 6; ++i) {
      const int c = tid + i * NTHR;
      if (c < nch) *(uint4*)(U + (c >> 4) * 136 + (c & 15) * 8) = sv[i];
    }
    const bfraw* Wp = (const bfraw*)(p.ws + WS_W) + WE_POOL + g * 128 * 128;
    uint4 wv4[4];
#pragma unroll
    for (int i = 0; i < 4; ++i) { int c = tid + i * 512; wv4[i] = *(const uint4*)(Wp + (c >> 4) * 128 + (c & 15) * 8); }
#pragma unroll
    for (int i = 0; i < 4; ++i) { int c = tid + i * 512; *(uint4*)(sW + (c >> 4) * 136 + (c & 15) * 8) = wv4[i]; }
  }
  __syncthreads();
  {
    const int rl = tid >> 3, cg8 = tid & 7;
    const int lrow = isP ? 15 + rl : (rl >> 3) * 23 + 15 + (rl & 7);
    float sum[16], cur[16];
#pragma unroll
    for (int j = 0; j < 16; ++j) { sum[j] = 0.f; cur[j] = 0.f; }
    float cnt = (float)wnd;
    if (isP) cnt = (float)min(wnd, t0 + rl + 1);
    for (int i = 0; i < wnd; ++i) {
      float f[16];
      const bfraw* s = U + (lrow - i) * 136 + cg8 * 16;
      unpack8(*(const uint4*)s, f); unpack8(*(const uint4*)(s + 8), f + 8);
#pragma unroll
      for (int j = 0; j < 16; ++j) sum[j] += f[j];
      if (i == 0) {
#pragma unroll
        for (int j = 0; j < 16; ++j) cur[j] = f[j];
      }
    }
    float d[16];
    const float ic = 1.f / cnt;
#pragma unroll
    for (int j = 0; j < 16; ++j) d[j] = (rl < nrows) ? (sum[j] * ic - cur[j]) : 0.f;
    *(uint4*)(dA + rl * 136 + cg8 * 16) = pack8(d);
    *(uint4*)(dA + rl * 136 + cg8 * 16 + 8) = pack8(d + 8);
  }
  __syncthreads();
  f32x4 acc[4];
#pragma unroll
  for (int i = 0; i < 4; ++i) acc[i] = (f32x4){0.f, 0.f, 0.f, 0.f};
#pragma unroll
  for (int kk = 0; kk < 4; ++kk) {
    bf16x8 bfr = *(const bf16x8*)(sW + (w * 16 + r) * 136 + kk * 32 + q * 8);
#pragma unroll
    for (int mt = 0; mt < 4; ++mt) {
      bf16x8 af = *(const bf16x8*)(dA + (mt * 16 + r) * 136 + kk * 32 + q * 8);
      acc[mt] = mfma16(af, bfr, acc[mt]);
    }
  }
  const float sc = p.pool_scale[l * 512 + g * 128 + w * 16 + r];
#pragma unroll
  for (int mt = 0; mt < 4; ++mt)
#pragma unroll
    for (int gg = 0; gg < 4; ++gg) {
      int rl = mt * 16 + q * 4 + gg;
      if (rl < nrows) OA[(size_t)(grow0 + rl) * 512 + g * 128 + w * 16 + r] = f2bf(acc[mt][gg] * sc);
    }
  __syncthreads();
}

constexpr int L_W = 0;
constexpr int L_QG = 17408;
constexpr int L_KGT = 34816;
constexpr int L_QK = 53248;
constexpr int L_UT = 62464;
constexpr int L_ST = 80896;
constexpr int L_DLT = 115712;
constexpr int L_PART = 134144;
constexpr int L_RHS = 80896;
constexpr int L_MM = 80896 + 65536;
constexpr int L_MISC = 162816;
constexpr int LDS_BYTES = 163840;

__device__ __forceinline__ int dchunk_lds(int c) {
  if (c < 2048) { int a = c >> 10, cl = c & 1023; return (a ? L_QG : L_W) + (cl >> 4) * 272 + (cl & 15) * 16; }
  if (c < 3072) { int cl = c - 2048; return L_KGT + (cl >> 3) * 144 + (cl & 7) * 16; }
  if (c < 3584) { int cl = c - 3072; return L_QK + (cl >> 3) * 144 + (cl & 7) * 16; }
  int cl = c - 3584; return L_UT + (cl >> 3) * 144 + (cl & 7) * 16;
}

__device__ __forceinline__ float delta_prep(const Params& p, int l, int h, bool isP, int grow0, int t0, int nvalid, int bb, char* sm) {
  const int tid = opq(threadIdx.x), lane = tid & 63, w = tid >> 6, r = lane & 15, q = lane >> 4;
  const bfraw* B1 = (const bfraw*)(p.ws + WS_B1);
  const float* BA = (const float*)(p.ws + WS_BA);
  bfraw* raw = (bfraw*)(sm + L_RHS);
  float* misc = (float*)(sm + L_MISC);
  {
    uint4 sv[7];
#pragma unroll
    for (int i = 0; i < 7; ++i) {
      const int c = tid + i * NTHR;
      uint4 v = make_uint4(0u, 0u, 0u, 0u);
      if (c < 3 * 67 * 16) {
        int arr = c / 1072, rem = c - arr * 1072, rr = rem >> 4, ch = rem & 15;
        int tl = rr - 3;
        const int col = 512 + arr * 512 + h * 128 + ch * 8;
        if (isP) {
          if (t0 + tl >= 0 && tl < nvalid) v = *(const uint4*)(B1 + (size_t)(grow0 + tl) * LD1 + col);
        } else {
          if (tl >= 0) { if (tl < nvalid) v = *(const uint4*)(B1 + (size_t)(grow0 + tl) * LD1 + col); }
          else {
            const float* s = p.state_conv + ((size_t)(l * NBS + bb) * 3 + rr) * 1536 + arr * 512 + h * 128 + ch * 8;
            float4 f0 = *(const float4*)s, f1 = *(const float4*)(s + 4);
            v.x = pack2(f0.x, f0.y); v.y = pack2(f0.z, f0.w); v.z = pack2(f1.x, f1.y); v.w = pack2(f1.z, f1.w);
          }
        }
      }
      sv[i] = v;
    }
#pragma unroll
    for (int i = 0; i < 7; ++i) {
      const int c = tid + i * NTHR;
      if (c < 3 * 67 * 16) {
        int arr = c / 1072, rem = c - arr * 1072, rr = rem >> 4, ch = rem & 15;
        *(uint4*)(raw + (arr * 67 + rr) * 136 + ch * 8) = sv[i];
      }
    }
  }
  if (w == 0) {
    float bt = 0.f, g = 0.f;
    if (lane < nvalid) {
      const float* ba = BA + (size_t)(grow0 + lane) * 8;
      bt = sigmoidf_(ba[h]);
      float xa = ba[4 + h] + p.dt_bias[l * 4 + h];
      float sp = fmaxf(xa, 0.f) + log1pf(expf(-fabsf(xa)));
      g = -expf(p.a_log[l * 4 + h]) * sp;
    }
    float G = g;
#pragma unroll
    for (int o = 1; o < 64; o <<= 1) { float t = __shfl_up(G, o); if (lane >= o) G += t; }
    misc[lane] = G; misc[64 + lane] = bt; misc[128 + lane] = expf(G);
  }
  __syncthreads();
  const int rl = tid >> 3, cg8 = tid & 7;
  float qf[16], kf[16], vf[16];
  {
    const float* cw = p.conv_w + (size_t)l * 4 * 1536 + h * 128 + cg8 * 16;
#pragma unroll
    for (int arr = 0; arr < 3; ++arr) {
      float y[16];
#pragma unroll
      for (int j = 0; j < 16; ++j) y[j] = 0.f;
      if (rl < nvalid) {
#pragma unroll
      for (int j = 0; j < 4; ++j) {
        float f[16], wv[16];
        const bfraw* s = raw + (arr * 67 + rl + j) * 136 + cg8 * 16;
        unpack8(*(const uint4*)s, f); unpack8(*(const uint4*)(s + 8), f + 8);
#pragma unroll
        for (int e = 0; e < 4; ++e) {
          float4 t4 = *(const float4*)(cw + j * 1536 + arr * 512 + e * 4);
          wv[e * 4] = t4.x; wv[e * 4 + 1] = t4.y; wv[e * 4 + 2] = t4.z; wv[e * 4 + 3] = t4.w;
        }
#pragma unroll
        for (int e = 0; e < 16; ++e) y[e] += f[e] * wv[e];
      }
      float ss = 0.f;
#pragma unroll
      for (int e = 0; e < 16; ++e) { float v = y[e]; v = v * sigmoidf_(v); y[e] = v; ss += v * v; }
      if (arr < 2) {
        ss += __shfl_xor(ss, 1); ss += __shfl_xor(ss, 2); ss += __shfl_xor(ss, 4);
        float sc = rsqrtf(ss + EPS) * (arr == 0 ? 0.08838834764831845f : 1.f);
#pragma unroll
        for (int e = 0; e < 16; ++e) y[e] *= sc;
      }
      }
      const bool ok = rl < nvalid;
#pragma unroll
      for (int e = 0; e < 16; ++e) {
        float v = ok ? y[e] : 0.f;
        if (arr == 0) qf[e] = v; else if (arr == 1) kf[e] = v; else vf[e] = v;
      }
    }
    bfraw* qh = (bfraw*)(sm + L_QG);
    bfraw* kh = (bfraw*)(sm + L_W);
    *(uint4*)(qh + rl * 136 + cg8 * 16) = pack8(qf); *(uint4*)(qh + rl * 136 + cg8 * 16 + 8) = pack8(qf + 8);
    *(uint4*)(kh + rl * 136 + cg8 * 16) = pack8(kf); *(uint4*)(kh + rl * 136 + cg8 * 16 + 8) = pack8(kf + 8);
  }
  __syncthreads();
  {
    float* rhs = (float*)(sm + L_RHS);
    const float bt = misc[64 + rl], eg = misc[128 + rl];
#pragma unroll
    for (int e = 0; e < 16; ++e) {
      rhs[rl * 256 + cg8 * 16 + e] = vf[e] * bt;
      rhs[rl * 256 + 128 + cg8 * 16 + e] = kf[e] * bt * eg;
    }
  }
  {
    const bfraw* kh = (const bfraw*)(sm + L_W);
    const bfraw* ah = (w < 4) ? kh : (const bfraw*)(sm + L_QG);
    const int mt = w & 3;
    f32x4 acc[4];
#pragma unroll
    for (int i = 0; i < 4; ++i) acc[i] = (f32x4){0.f, 0.f, 0.f, 0.f};
#pragma unroll
    for (int kk = 0; kk < 4; ++kk) {
      bf16x8 af = *(const bf16x8*)(ah + (mt * 16 + r) * 136 + kk * 32 + q * 8);
#pragma unroll
      for (int nt = 0; nt < 4; ++nt) {
        bf16x8 bfr = *(const bf16x8*)(kh + (nt * 16 + r) * 136 + kk * 32 + q * 8);
        acc[nt] = mfma16(af, bfr, acc[nt]);
      }
    }
    float* Mm = (float*)(sm + L_MM);
    bfraw* qk = (bfraw*)(sm + L_QK);
#pragma unroll
    for (int nt = 0; nt < 4; ++nt)
#pragma unroll
      for (int g = 0; g < 4; ++g) {
        const int i = mt * 16 + q * 4 + g, j = nt * 16 + r;
        const float Gi = misc[i], Gj = misc[j];
        if (w < 4) {
          float v = (j < i) ? acc[nt][g] * __expf(Gi - Gj) * misc[64 + i] : 0.f;
          Mm[j * 64 + i] = v;
          ((bfraw*)(sm + L_KGT))[i * 72 + j] = f2bf(v);
        } else {
          float v = (j <= i) ? acc[nt][g] * __expf(Gi - Gj) : 0.f;
          qk[i * 72 + j] = f2bf(v);
        }
      }
  }
  __syncthreads();
  bfraw* XTu = (bfraw*)(sm + L_UT);
  bfraw* XTw = (bfraw*)(sm + L_W);
  {
    const uint4 z4 = make_uint4(0u, 0u, 0u, 0u);
    for (int c = tid; c < 128 * 9; c += NTHR) { *(uint4*)(XTu + c * 8) = z4; *(uint4*)(XTw + c * 8) = z4; }
  }
  __syncthreads();
  {
    float* xs = (float*)(sm + L_RHS);
    const float* MT = (const float*)(sm + L_MM);
    const bfraw* Mb = (const bfraw*)(sm + L_KGT);
#pragma unroll
    for (int ib = 0; ib < 4; ++ib) {
      if (ib * 16 >= nvalid) break;
      if (ib > 0) {
        f32x4 a0 = (f32x4){0.f, 0.f, 0.f, 0.f}, a1 = a0;
        const bfraw* xb0 = (w < 4) ? XTu + ((2 * w) * 16 + r) * 72 : XTw + ((2 * w - 8) * 16 + r) * 72;
        const bfraw* xb1 = xb0 + 16 * 72;
#pragma unroll
        for (int kk = 0; kk < 2; ++kk) {
          if (kk * 32 < ib * 16) {
            bf16x8 am = *(const bf16x8*)(Mb + (ib * 16 + r) * 72 + kk * 32 + q * 8);
            bf16x8 b0 = *(const bf16x8*)(xb0 + kk * 32 + q * 8);
            bf16x8 b1 = *(const bf16x8*)(xb1 + kk * 32 + q * 8);
            a0 = mfma16(am, b0, a0);
            a1 = mfma16(am, b1, a1);
          }
        }
#pragma unroll
        for (int g = 0; g < 4; ++g) {
          float* rp = xs + (ib * 16 + q * 4 + g) * 256 + w * 32 + r;
          rp[0] -= a0[g];
          rp[16] -= a1[g];
        }
        __syncthreads();
      }
      if (tid < 256) {
        float a[16];
#pragma unroll
        for (int ii = 0; ii < 16; ++ii) a[ii] = xs[(ib * 16 + ii) * 256 + tid];
#pragma unroll
        for (int j = 0; j < 16; ++j) {
          const float xj = a[j];
          const float* mp = MT + (ib * 16 + j) * 64 + ib * 16;
#pragma unroll
          for (int ii = j + 1; ii < 16; ++ii) a[ii] -= mp[ii] * xj;
        }
        bfraw* dst = (tid < 128) ? XTu + tid * 72 + ib * 16 : XTw + (tid - 128) * 72 + ib * 16;
        *(uint4*)dst = pack8(a);
        *(uint4*)(dst + 8) = pack8(a + 8);
      }
      __syncthreads();
    }
  }
  uint4 wreg[8];
  if (tid >= 128 && tid < 256) {
#pragma unroll
    for (int c = 0; c < 8; ++c) wreg[c] = *(const uint4*)(XTw + (tid - 128) * 72 + c * 8);
  }
  __syncthreads();
  if (tid >= 128 && tid < 256) {
    bfraw* wl = (bfraw*)(sm + L_W);
#pragma unroll
    for (int c = 0; c < 8; ++c) {
      const unsigned u4[4] = {wreg[c].x, wreg[c].y, wreg[c].z, wreg[c].w};
#pragma unroll
      for (int e = 0; e < 4; ++e) {
        wl[(c * 8 + e * 2) * 136 + (tid - 128)] = (bfraw)(u4[e] & 0xffffu);
        wl[(c * 8 + e * 2 + 1) * 136 + (tid - 128)] = (bfraw)(u4[e] >> 16);
      }
    }
  }
  const float Glast = misc[63];
  {
    const float eg = misc[128 + rl];
    const float ek = __expf(Glast - misc[rl]);
    bfraw* qg = (bfraw*)(sm + L_QG);
    bfraw* kgT = (bfraw*)(sm + L_KGT);
    float t[16];
#pragma unroll
    for (int e = 0; e < 16; ++e) t[e] = qf[e] * eg;
    *(uint4*)(qg + rl * 136 + cg8 * 16) = pack8(t); *(uint4*)(qg + rl * 136 + cg8 * 16 + 8) = pack8(t + 8);
#pragma unroll
    for (int e = 0; e < 16; ++e) kgT[(cg8 * 16 + e) * 72 + rl] = f2bf(kf[e] * ek);
  }
  const float gl = expf(Glast);
  __syncthreads();
  return gl;
}

constexpr int L_KGT2 = 124928;
constexpr int L_QK2 = 143360;
__device__ __forceinline__ void write_St2(const f32x4 (&S)[2], char* sm) {
  const int tid_ = opq(threadIdx.x);
  const int lane = tid_ & 63, w = tid_ >> 6, r = lane & 15, q = lane >> 4;
  bfraw* St = (bfraw*)(sm + L_ST);
#pragma unroll
  for (int nd = 0; nd < 2; ++nd) {
    uint2 v; v.x = pack2(S[nd][0], S[nd][1]); v.y = pack2(S[nd][2], S[nd][3]);
    *(uint2*)(St + (nd * 16 + r) * 136 + w * 16 + q * 4) = v;
  }
}
__device__ __forceinline__ void step_part1(char* sm, int off_ut, f32x4& o) {
  const int tid_ = opq(threadIdx.x);
  const int lane = tid_ & 63, w = tid_ >> 6, r = lane & 15, q = lane >> 4;
  const int mj = w >> 1, nd = w & 1;
  const bfraw* wl = (const bfraw*)(sm + L_W);
  const bfraw* qg = (const bfraw*)(sm + L_QG);
  const bfraw* uT = (const bfraw*)(sm + off_ut);
  const bfraw* St = (const bfraw*)(sm + L_ST);
  bfraw* dltT = (bfraw*)(sm + L_DLT);
  f32x4 dl = (f32x4){0.f, 0.f, 0.f, 0.f};
  o = (f32x4){0.f, 0.f, 0.f, 0.f};
#pragma unroll
  for (int kk = 0; kk < 4; ++kk) {
    bf16x8 sb = *(const bf16x8*)(St + (nd * 16 + r) * 136 + kk * 32 + q * 8);
    bf16x8 aw = *(const bf16x8*)(wl + (mj * 16 + r) * 136 + kk * 32 + q * 8);
    bf16x8 aq = *(const bf16x8*)(qg + (mj * 16 + r) * 136 + kk * 32 + q * 8);
    dl = mfma16(aw, sb, dl);
    o = mfma16(aq, sb, o);
  }
  uint2 uv = *(const uint2*)(uT + (nd * 16 + r) * 72 + mj * 16 + q * 4);
  uint2 dv;
  dv.x = pack2(lo2f(uv.x) - dl[0], hi2f(uv.x) - dl[1]);
  dv.y = pack2(lo2f(uv.y) - dl[2], hi2f(uv.y) - dl[3]);
  *(uint2*)(dltT + (nd * 16 + r) * 72 + mj * 16 + q * 4) = dv;
}
__device__ __forceinline__ void step_part2(const Params& p, char* sm, int off_kgt, int off_qk, int h, int s, int grow0, int nvalid,
                                           float gl, f32x4& o, f32x4 (&S)[2]) {
  const int tid_ = opq(threadIdx.x);
  const int lane = tid_ & 63, w = tid_ >> 6, r = lane & 15, q = lane >> 4;
  const int mj = w >> 1, nd = w & 1;
  const bfraw* kgT = (const bfraw*)(sm + off_kgt);
  const bfraw* qk = (const bfraw*)(sm + off_qk);
  const bfraw* dltT = (const bfraw*)(sm + L_DLT);
#pragma unroll
  for (int g = 0; g < 4; ++g) { S[0][g] *= gl; S[1][g] *= gl; }
#pragma unroll
  for (int kk = 0; kk < 2; ++kk) {
    bf16x8 d0 = *(const bf16x8*)(dltT + (r) * 72 + kk * 32 + q * 8);
    bf16x8 d1 = *(const bf16x8*)(dltT + (16 + r) * 72 + kk * 32 + q * 8);
    bf16x8 aqk = *(const bf16x8*)(qk + (mj * 16 + r) * 72 + kk * 32 + q * 8);
    bf16x8 ak = *(const bf16x8*)(kgT + (w * 16 + r) * 72 + kk * 32 + q * 8);
    o = mfma16(aqk, nd ? d1 : d0, o);
    S[0] = mfma16(ak, d0, S[0]);
    S[1] = mfma16(ak, d1, S[1]);
  }
  write_St2(S, sm);
  bfraw* OB = (bfraw*)(p.ws + WS_B1);
#pragma unroll
  for (int g = 0; g < 4; ++g) {
    const int j = mj * 16 + q * 4 + g;
    if (j < nvalid) OB[(size_t)(grow0 + j) * LD1 + h * 128 + s * 32 + nd * 16 + r] = f2bf(o[g]);
  }
}
__device__ __forceinline__ int s2_lane_off(int s) {
  const int tid_ = opq(threadIdx.x);
  const int lane = tid_ & 63, w = tid_ >> 6, r = lane & 15, q = lane >> 4;
  int off = (w * 16 + q * 4) * 128 + s * 32 + r;
  asm volatile("" : "+v"(off));
  return off;
}
__device__ __forceinline__ void store_S2(const f32x4 (&S)[2], float* dst, int s) {
  float* b = dst + s2_lane_off(s);
#pragma unroll
  for (int nd = 0; nd < 2; ++nd)
#pragma unroll
    for (int g = 0; g < 4; ++g) b[g * 128 + nd * 16] = S[nd][g];
}
__device__ __forceinline__ void load_S2(f32x4 (&S)[2], const float* src, int s) {
  const float* b = src + s2_lane_off(s);
#pragma unroll
  for (int nd = 0; nd < 2; ++nd)
#pragma unroll
    for (int g = 0; g < 4; ++g) S[nd][g] = b[g * 128 + nd * 16];
}

__device__ __forceinline__ void f1_unit(const Params& p, int l, int u, char* sm) {
  const int b = u / (NCH * 4), rem = u - b * NCH * 4, c = rem >> 2, h = rem & 3;
  int t0, nvalid;
  if (c == 0) { t0 = 0; nvalid = 16; } else { t0 = 16 + (c - 1) * 64; nvalid = 64; }
  float gl = delta_prep(p, l, h, true, b * TP + t0, t0, nvalid, 0, sm);
  bfraw* D = (bfraw*)(p.ws + WS_D) + (size_t)u * DUNIT;
  for (int cidx = opq(threadIdx.x); cidx < 4608; cidx += NTHR)
    *(uint4*)(D + (size_t)cidx * 8) = *(const uint4*)(sm + dchunk_lds(cidx));
  if (opq(threadIdx.x) == 0) ((float*)(p.ws + WS_GL))[u] = gl;
  __syncthreads();
}

__device__ __forceinline__ void sample_delta_unit(const Params& p, int l, int su, char* sm) {
  const int bb = su >> 2, h = su & 3;
  const int grow0 = ROWS_P + bb * TS;
  float gl = delta_prep(p, l, h, false, grow0, 0, TS, bb, sm);
  const float* S0 = p.state_delta + ((size_t)(l * NBS + bb) * 4 + h) * 128 * 128;
  float* S1 = p.out + O_DELTAS + ((size_t)(l * NBS + bb) * 4 + h) * 128 * 128;
#pragma unroll 1
  for (int s = 0; s < 4; ++s) {
    f32x4 S[2], o;
    load_S2(S, S0, s);
    write_St2(S, sm);
    __syncthreads();
    step_part1(sm, L_UT + s * 32 * 144, o);
    __syncthreads();
    step_part2(p, sm, L_KGT, L_QK, h, s, grow0, TS, gl, o, S);
    store_S2(S, S1, s);
  }
  __syncthreads();
}

__device__ __forceinline__ void scan_unit(const Params& p, int l, int bhs, char* sm) {
  const int s = (bhs >> 3) & 3, bh = (bhs & 7) * 2 + (bhs >> 5), b = bh >> 2, h = bh & 3;
  const int tid = opq(threadIdx.x);
  f32x4 S[2];
  S[0] = (f32x4){0.f, 0.f, 0.f, 0.f}; S[1] = (f32x4){0.f, 0.f, 0.f, 0.f};
  write_St2(S, sm);
  const float* GL = (const float*)(p.ws + WS_GL);
  uint4 a0, a1, a2, a3, a4, a5, a6, a7, b0, b1, b2, b3, b4, b5, b6, b7;
  float gla, glb;
#define PRE_LOAD(P, GLV, C) { const int cc_ = ((C) < NCH) ? (C) : NCH - 1; const int U_ = (b * NCH + cc_) * 4 + h; \
    const bfraw* D_ = (const bfraw*)(p.ws + WS_D) + (size_t)U_ * DUNIT + (size_t)tid * 8; \
    P##0 = *(const uint4*)(D_); P##1 = *(const uint4*)(D_ + 4096); P##2 = *(const uint4*)(D_ + 2 * 4096); P##3 = *(const uint4*)(D_ + 3 * 4096); \
    P##4 = *(const uint4*)(D_ + 4 * 4096); P##5 = *(const uint4*)(D_ + 5 * 4096); P##6 = *(const uint4*)(D_ + 6 * 4096); \
    P##7 = *(const uint4*)(D_ + 7 * 4096 + s * 2048 - ((tid >= 256) ? 2048 : 0)); GLV = GL[U_]; }
#define LDS_PUT(P, KB) { \
    *(uint4*)(sm + L_W + (tid >> 4) * 272 + (tid & 15) * 16) = P##0; \
    *(uint4*)(sm + L_W + (32 + (tid >> 4)) * 272 + (tid & 15) * 16) = P##1; \
    *(uint4*)(sm + L_QG + (tid >> 4) * 272 + (tid & 15) * 16) = P##2; \
    *(uint4*)(sm + L_QG + (32 + (tid >> 4)) * 272 + (tid & 15) * 16) = P##3; \
    *(uint4*)(sm + ((KB) ? L_KGT2 : L_KGT) + (tid >> 3) * 144 + (tid & 7) * 16) = P##4; \
    *(uint4*)(sm + ((KB) ? L_KGT2 : L_KGT) + (64 + (tid >> 3)) * 144 + (tid & 7) * 16) = P##5; \
    *(uint4*)(sm + ((KB) ? L_QK2 : L_QK) + (tid >> 3) * 144 + (tid & 7) * 16) = P##6; \
    if (tid < 256) *(uint4*)(sm + L_UT + (tid >> 3) * 144 + (tid & 7) * 16) = P##7; }
#define SCAN_STEP(C, KB, GLV) { \
    __syncthreads(); \
    int t0_, nv_; \
    if ((C) == 0) { t0_ = 0; nv_ = 16; } else { t0_ = 16 + ((C) - 1) * 64; nv_ = 64; } \
    f32x4 o_; \
    step_part1(sm, L_UT, o_); \
    __syncthreads(); \
    step_part2(p, sm, (KB) ? L_KGT2 : L_KGT, (KB) ? L_QK2 : L_QK, h, s, b * TP + t0_, nv_, GLV, o_, S); }
  PRE_LOAD(a, gla, 0)
  PRE_LOAD(b, glb, 1)
  for (int c = 0; c < NCH; c += 2) {
    LDS_PUT(a, 0)
    const float gl0 = gla;
    PRE_LOAD(a, gla, c + 2)
    SCAN_STEP(c, 0, gl0)
    if (c + 1 < NCH) {
      LDS_PUT(b, 1)
      const float gl1 = glb;
      PRE_LOAD(b, glb, c + 3)
      SCAN_STEP(c + 1, 1, gl1)
    }
  }
  store_S2(S, p.out + O_DELTAP + ((size_t)(l * NBP + b) * 4 + h) * 128 * 128, s);
#undef PRE_LOAD
#undef LDS_PUT
#undef SCAN_STEP
}

__device__ __forceinline__ void ob_finalize(const Params& p, int l) {
  const int tid = opq(threadIdx.x), lane = tid & 63, w = tid >> 6;
  bfraw* OB = (bfraw*)(p.ws + WS_B1);
  const bfraw* B2 = (const bfraw*)(p.ws + WS_B2);
  float ow[8];
#pragma unroll
  for (int e = 0; e < 8; ++e) ow[e] = p.onorm_w[l * 128 + (lane & 15) * 8 + e];
  for (int r0 = blockIdx.x * 8 + w; r0 < ROWS; r0 += gridDim.x * 8 * 2) {
    uint4 ov[2], zv[2];
#pragma unroll
    for (int k = 0; k < 2; ++k) {
      const int row = r0 + k * gridDim.x * 8;
      if (row < ROWS) {
        ov[k] = *(const uint4*)(OB + (size_t)row * LD1 + lane * 8);
        zv[k] = *(const uint4*)(B2 + (size_t)row * LD2 + lane * 8);
      } else { ov[k] = make_uint4(0u, 0u, 0u, 0u); zv[k] = ov[k]; }
    }
#pragma unroll
    for (int k = 0; k < 2; ++k) {
      const int row = r0 + k * gridDim.x * 8;
      float o[8], z[8];
      unpack8(ov[k], o); unpack8(zv[k], z);
      float ss = 0.f;
#pragma unroll
      for (int e = 0; e < 8; ++e) ss += o[e] * o[e];
      ss += __shfl_xor(ss, 1); ss += __shfl_xor(ss, 2); ss += __shfl_xor(ss, 4); ss += __shfl_xor(ss, 8);
      const float rinv = rsqrtf(ss * (1.f / 128.f) + EPS);
#pragma unroll
      for (int e = 0; e < 8; ++e) o[e] = o[e] * rinv * ow[e] * (z[e] * sigmoidf_(z[e]));
      if (row < ROWS) *(uint4*)(OB + (size_t)row * LD1 + lane * 8) = pack8(o);
    }
  }
}

__device__ __forceinline__ void swa_item(const Params& p, int l, int it, char* sm) {
  const int tid = opq(threadIdx.x), lane = tid & 63, w = tid >> 6, r = lane & 15, q = lane >> 4;
  bfraw* Qs = (bfraw*)sm;
  bfraw* Ks = (bfraw*)(sm + 36864);
  bfraw* VT = (bfraw*)(sm + 36864 + 27648);
  bfraw* B2 = (bfraw*)(p.ws + WS_B2);
  const int NPI = NBP * 2 * NCH;
  bool isP = it < NPI;
  int kvh, qrow0, nq, bb = 0, q0 = 0, rowb;
  if (isP) {
    int b = it / (2 * NCH), rem = it - b * 2 * NCH; kvh = rem / NCH; int qt = rem - kvh * NCH;
    q0 = qt * 64; nq = min(64, TP - q0); rowb = b * TP; qrow0 = rowb + q0;
  } else {
    int s = it - NPI; bb = s >> 1; kvh = s & 1; nq = TS; rowb = ROWS_P + bb * TS; qrow0 = rowb;
  }
#pragma unroll
  for (int i = 0; i < 4; ++i) {
    int c = tid + i * 512; int rr = c >> 3, ch = c & 7; int g = rr >> 6, t = rr & 63;
    uint4 v = make_uint4(0u, 0u, 0u, 0u);
    if (t < nq) v = *(const uint4*)(B2 + (size_t)(qrow0 + t) * LD2 + 512 + (kvh * 4 + g) * 64 + ch * 8);
    *(uint4*)(Qs + rr * 72 + ch * 8) = v;
  }
#pragma unroll
  for (int i = 0; i < 3; ++i) {
    int c = tid + i * 512; int j = c >> 3, ch = c & 7;
    uint4 v = make_uint4(0u, 0u, 0u, 0u);
    if (isP) {
      int pos = q0 - 128 + j;
      if (pos >= 0 && pos < TP) v = *(const uint4*)(B2 + (size_t)(rowb + pos) * LD2 + 1024 + kvh * 64 + ch * 8);
    } else {
      if (j < 128) {
        const float* s = p.cache_k + (((size_t)(l * NBS + bb) * 128 + j) * 2 + kvh) * 64 + ch * 8;
        float f[8];
#pragma unroll
        for (int e = 0; e < 8; ++e) f[e] = s[e];
        v = pack8(f);
      } else if (j < 128 + TS) v = *(const uint4*)(B2 + (size_t)(rowb + j - 128) * LD2 + 1024 + kvh * 64 + ch * 8);
    }
    *(uint4*)(Ks + j * 72 + ch * 8) = v;
  }
#pragma unroll
  for (int ci = 0; ci < 3; ++ci) {
    const int c = tid + ci * NTHR;
    int ch = c / 192, j = c - ch * 192;
    float f[8];
#pragma unroll
    for (int e = 0; e < 8; ++e) f[e] = 0.f;
    if (isP) {
      int pos = q0 - 128 + j;
      if (pos >= 0 && pos < TP) unpack8(*(const uint4*)(B2 + (size_t)(rowb + pos) * LD2 + 1152 + kvh * 64 + ch * 8), f);
    } else {
      if (j < 128) {
        const float* s = p.cache_v + (((size_t)(l * NBS + bb) * 128 + j) * 2 + kvh) * 64 + ch * 8;
#pragma unroll
        for (int e = 0; e < 8; ++e) f[e] = s[e];
      } else if (j < 128 + TS) unpack8(*(const uint4*)(B2 + (size_t)(rowb + j - 128) * LD2 + 1152 + kvh * 64 + ch * 8), f);
    }
#pragma unroll
    for (int e = 0; e < 8; ++e) VT[(ch * 8 + e) * 200 + j] = f2bf(f[e]);
  }
  __syncthreads();
  const int g = w >> 1, qh = w & 1;
  const float sink = p.sinks[l * 8 + kvh * 4 + g];
  const int jmin = isP ? max(0, 128 - q0) : 0;
#pragma unroll 1
  for (int nt = 0; nt < 2; ++nt) {
    const int tq0 = qh * 32 + nt * 16;
    if (tq0 >= nq) break;
    bf16x8 qf[2];
#pragma unroll
    for (int kk = 0; kk < 2; ++kk) qf[kk] = *(const bf16x8*)(Qs + (g * 64 + tq0 + r) * 72 + kk * 32 + q * 8);
    const int mt0 = tq0 >> 4;
    f32x4 s[9];
#pragma unroll
    for (int i = 0; i < 9; ++i) {
      s[i] = (f32x4){0.f, 0.f, 0.f, 0.f};
#pragma unroll
      for (int kk = 0; kk < 2; ++kk) {
        bf16x8 kf = *(const bf16x8*)(Ks + ((mt0 + i) * 16 + r) * 72 + kk * 32 + q * 8);
        s[i] = mfma16(kf, qf[kk], s[i]);
      }
    }
    const int t = tq0 + r;
    float mx = sink;
#pragma unroll
    for (int i = 0; i < 9; ++i)
#pragma unroll
      for (int gg = 0; gg < 4; ++gg) {
        const int j = (mt0 + i) * 16 + q * 4 + gg;
        const bool ok = (j >= t + 1) && (j <= 128 + t) && (j >= jmin) && (t < nq);
        float v = ok ? s[i][gg] : -INFINITY;
        s[i][gg] = v;
        mx = fmaxf(mx, v);
      }
    mx = fmaxf(mx, __shfl_xor(mx, 16)); mx = fmaxf(mx, __shfl_xor(mx, 32));
    float sum = 0.f;
#pragma unroll
    for (int i = 0; i < 9; ++i)
#pragma unroll
      for (int gg = 0; gg < 4; ++gg) {
        float e = __expf(s[i][gg] - mx);
        s[i][gg] = e;
        sum += e;
      }
    sum += __shfl_xor(sum, 16); sum += __shfl_xor(sum, 32);
    const float inv = 1.f / (sum + __expf(sink - mx));
    f32x4 o[4];
#pragma unroll
    for (int dm = 0; dm < 4; ++dm) o[dm] = (f32x4){0.f, 0.f, 0.f, 0.f};
#pragma unroll
    for (int ks = 0; ks < 5; ++ks) {
      union { bf16x8 v; unsigned u[4]; } cv;
      cv.u[0] = pack2(s[2 * ks][0], s[2 * ks][1]);
      cv.u[1] = pack2(s[2 * ks][2], s[2 * ks][3]);
      if (ks < 4) { cv.u[2] = pack2(s[2 * ks + 1][0], s[2 * ks + 1][1]); cv.u[3] = pack2(s[2 * ks + 1][2], s[2 * ks + 1][3]); }
      else { cv.u[2] = 0u; cv.u[3] = 0u; }
      const int kb = (mt0 + 2 * ks) * 16;
#pragma unroll
      for (int dm = 0; dm < 4; ++dm) {
        union { bf16x8 v; uint2 u[2]; } av;
        av.u[0] = *(const uint2*)(VT + (dm * 16 + r) * 200 + kb + q * 4);
        if (ks < 4) av.u[1] = *(const uint2*)(VT + (dm * 16 + r) * 200 + kb + 16 + q * 4);
        else av.u[1] = make_uint2(0u, 0u);
        o[dm] = mfma16(av.v, cv.v, o[dm]);
      }
    }
    if (t < nq) {
#pragma unroll
      for (int dm = 0; dm < 4; ++dm) {
        uint2 v;
        v.x = pack2(o[dm][0] * inv, o[dm][1] * inv);
        v.y = pack2(o[dm][2] * inv, o[dm][3] * inv);
        *(uint2*)(B2 + (size_t)(qrow0 + t) * LD2 + 512 + (kvh * 4 + g) * 64 + dm * 16 + q * 4) = v;
      }
    }
  }
  __syncthreads();
}

__device__ __forceinline__ float4 ld4bf(const bfraw* s) { uint2 v = *(const uint2*)s; return make_float4(lo2f(v.x), hi2f(v.x), lo2f(v.y), hi2f(v.y)); }
__device__ __forceinline__ void state_copies(const Params& p, int l, int bid, int nb) {
  const bfraw* B1 = (const bfraw*)(p.ws + WS_B1);
  const bfraw* B2 = (const bfraw*)(p.ws + WS_B2);
  constexpr int N0 = 4 * 15 * 512, N1 = 4 * 3 * 1536, N2 = 128 * 15 * 512, N3 = 128 * 3 * 1536, N4 = 4 * 128 * 128, N5 = 128 * 128 * 128;
  constexpr int TOT = N0 + N1 + N2 + N3 + 2 * N4 + 2 * N5;
#pragma unroll 4
  for (int i = (bid * NTHR + opq(threadIdx.x)) * 4; i < TOT; i += nb * NTHR * 4) {
    int e = i;
    float4 v; float* dst;
    if (e < N0) { int b = e / (15 * 512), rem = e % (15 * 512), j = rem >> 9, c = rem & 511;
      v = ld4bf(B1 + (size_t)(b * TP + 8193 + j) * LD1 + c); dst = p.out + O_POOLP + (size_t)l * N0 + e; }
    else if ((e -= N0) < N1) { int b = e / (3 * 1536), rem = e % (3 * 1536), j = rem / 1536, c = rem % 1536;
      v = ld4bf(B1 + (size_t)(b * TP + 8205 + j) * LD1 + 512 + c); dst = p.out + O_CONVP + (size_t)l * N1 + e; }
    else if ((e -= N1) < N2) { int b = e / (15 * 512), rem = e % (15 * 512), j = rem >> 9, c = rem & 511;
      if (j < 7) v = *(const float4*)(p.state_pool + ((size_t)(l * NBS + b) * 15 + j + 8) * 512 + c);
      else v = ld4bf(B1 + (size_t)(ROWS_P + b * TS + j - 7) * LD1 + c);
      dst = p.out + O_POOLS + (size_t)l * N2 + e; }
    else if ((e -= N2) < N3) { int b = e / (3 * 1536), rem = e % (3 * 1536), j = rem / 1536, c = rem % 1536;
      v = ld4bf(B1 + (size_t)(ROWS_P + b * TS + 5 + j) * LD1 + 512 + c); dst = p.out + O_CONVS + (size_t)l * N3 + e; }
    else if ((e -= N3) < 2 * N4) { int kv = e / N4, e2 = e % N4; int b = e2 >> 14, j = (e2 >> 7) & 127, c = e2 & 127;
      v = ld4bf(B2 + (size_t)(b * TP + 8080 + j) * LD2 + 1024 + kv * 128 + c); dst = p.out + (kv ? O_VP : O_KP) + (size_t)l * N4 + e2; }
    else { e -= 2 * N4; int kv = e / N5, e2 = e % N5; int b = e2 >> 14, j = (e2 >> 7) & 127, c = e2 & 127;
      const float* cache = kv ? p.cache_v : p.cache_k;
      if (j < 120) v = *(const float4*)(cache + ((size_t)(l * NBS + b) * 128 + j + 8) * 128 + c);
      else v = ld4bf(B2 + (size_t)(ROWS_P + b * TS + j - 120) * LD2 + 1024 + kv * 128 + c);
      dst = p.out + (kv ? O_VS : O_KS) + (size_t)l * N5 + e2; }
    *(float4*)dst = v;
  }
}

__device__ __forceinline__ void phase_f1(const Params& p, int l, char* sm) {
  constexpr int NPOOL = (NBP * NCH + 16) * 4;
  for (int it = blockIdx.x; it < NUNIT_P + NPOOL; it += gridDim.x) {
    if (it < NUNIT_P) f1_unit(p, l, it, sm);
    else pool_item(p, l, it - NUNIT_P, sm);
  }
  state_copies(p, l, blockIdx.x, gridDim.x);
}
__device__ __forceinline__ void phase_scan(const Params& p, int l, char* sm) {
  if (blockIdx.x < 64) { scan_unit(p, l, blockIdx.x, sm); return; }
  const int nb = gridDim.x - 64, bid = blockIdx.x - 64;
  constexpr int NSWA = NBP * 2 * NCH + NBS * 2;
  for (int it = bid; it < NSWA + NBS * 4; it += nb) {
    if (it < NSWA) swa_item(p, l, it, sm);
    else sample_delta_unit(p, l, it - NSWA, sm);
  }
  __syncthreads();
  phase_gate(p, sm, 0, nb, bid);
}

constexpr int NPHASE = 23;
#define PHASE(k, body) if (ph_lo <= (k) && (k) < ph_hi) { body; if ((k) + 1 < ph_hi) { if ((k) == 0) grid.sync(); else xcd_barrier(xb); } }
constexpr int L_XB = 163824;
__global__ void __launch_bounds__(NTHR, 2) fwd_kernel(Params p, int ph_lo, int ph_hi) {
  extern __shared__ __attribute__((aligned(16))) char sm[];
  cg::grid_group grid = cg::this_grid();
  if (threadIdx.x == 0) { *(volatile LAS unsigned*)(LAS char*)(sm + L_XB) = 0u; *(volatile LAS unsigned*)(LAS char*)(sm + L_XB + 4) = 0u; }
  __syncthreads();
  XcdBarrier xb = xcd_barrier_post((unsigned*)(p.ws + WS_BAR), (volatile LAS unsigned*)(LAS char*)(sm + L_XB));
  PHASE(0, { phase_tables(p); phase_convert(p, 0, sm); phase_norm(p, 0, p.norm1_w, p.w_in + 2560); })
  PHASE(1, phase_p1(p, sm))
  PHASE(2, phase_f1(p, 0, sm))
  PHASE(3, phase_scan(p, 0, sm))
  PHASE(4, { ob_finalize(p, 0); phase_gate(p, sm, 1, gridDim.x, blockIdx.x); })
  PHASE(5, phase_proj(p, sm))
  PHASE(6, phase_out(p, 0, sm))
  PHASE(7, phase_norm(p, 1, p.norm2_w, nullptr, 0, sm))
  PHASE(8, phase_up(p, sm))
  PHASE(9, phase_down(p, sm))
  PHASE(10, { down_reduce(p); phase_convert(p, 1, sm); })
  PHASE(11, phase_norm(p, 1, p.norm1_w + DM, p.w_in + (size_t)DM * D_IN + 2560))
  PHASE(12, phase_p1(p, sm))
  PHASE(13, phase_f1(p, 1, sm))
  PHASE(14, phase_scan(p, 1, sm))
  PHASE(15, { ob_finalize(p, 1); phase_gate(p, sm, 1, gridDim.x, blockIdx.x); })
  PHASE(16, phase_proj(p, sm))
  PHASE(17, phase_out(p, 1, sm))
  PHASE(18, phase_norm(p, 1, p.norm2_w + DM, nullptr, 1, sm))
  PHASE(19, phase_up(p, sm))
  PHASE(20, phase_down(p, sm))
  PHASE(21, down_reduce(p))
  PHASE(22, phase_final(p))
}

extern "C" void kernel_launch(void* const* d_in, const int* in_sizes, int n_in, void* d_out, int out_size, void* d_ws,
                              size_t ws_size, hipStream_t stream) {
  static int grid_blocks = 0;
  if (!grid_blocks) {
    hipFuncSetAttribute((const void*)fwd_kernel, hipFuncAttributeMaxDynamicSharedMemorySize, LDS_BYTES);
    int dev = 0, cus = 0, per_cu = 0;
    hipGetDevice(&dev);
    hipDeviceGetAttribute(&cus, hipDeviceAttributeMultiprocessorCount, dev);
    hipOccupancyMaxActiveBlocksPerMultiprocessor(&per_cu, fwd_kernel, NTHR, LDS_BYTES);
    if (per_cu < 1) per_cu = 1;
    if (per_cu > 1) per_cu = 1;
    grid_blocks = cus * per_cu;
  }
  Params p;
  memset(&p, 0, sizeof(p));
  const float** pp = (const float**)&p;
  for (int i = 0; i < 25; ++i) pp[i] = (const float*)d_in[i];
  p.out = (float*)d_out;
  p.ws = (char*)d_ws;
  if (ws_size < WS_END) { fprintf(stderr, "ws too small\n"); return; }
  hipMemsetAsync((char*)d_ws + WS_BAR, 0, 16384, stream);
#if ONE_LAUNCH
  int lo = 0, hi = NPHASE;
  void* args[] = {&p, &lo, &hi};
  hipError_t e = hipLaunchCooperativeKernel((const void*)fwd_kernel, dim3(grid_blocks), dim3(NTHR), args, LDS_BYTES, stream);
  if (e != hipSuccess) fprintf(stderr, "cooperative launch failed: %s (grid %d)\n", hipGetErrorString(e), grid_blocks);
#else
  for (int ph = 0; ph < NPHASE; ++ph)
    fwd_kernel<<<grid_blocks, NTHR, LDS_BYTES, stream>>>(p, ph, ph + 1);
#endif
}
```
